# Optimizing an MI355X kernel written in HIP

```python
import math
import jax, jax.numpy as jnp
from jax import lax
import numpy as np

D_MODEL = 1024
BATCH = 4
SEQ = 8192
DEPTH = 1
DEC_BATCH = 16
DEC_SEQ = 32
PAST_LEN = 2048

CHUNK = 64
GLA_HEADS = 4
GLA_DK = 64
GLA_DV = 128
GLA_LR = 16
GLA_GATE_TAU = 16.0
GDN_HEADS = 4
GDN_DK = 128
GDN_DV = 128
CONV_W = 4
GLA_QK = GLA_HEADS * GLA_DK
GLA_V = GLA_HEADS * GLA_DV
GDN_QK = GDN_HEADS * GDN_DK
GDN_V = GDN_HEADS * GDN_DV
GDN_QKV = 2 * GDN_QK + GDN_V
D_MIX = GLA_V + GDN_V
IN_SIZES = (GLA_QK, GLA_QK, GLA_V, GLA_LR, GLA_V, GDN_QKV, GDN_HEADS, GDN_HEADS, GDN_V)
N_IN = GLA_QK * 2 + GLA_V * 2 + GLA_LR + GDN_QKV + 2 * GDN_HEADS + GDN_V
PEER_HEADS = 8
PEER_QDIM = 256
PEER_HALF = PEER_QDIM // 2
N_KEYS = 128
N_EXPERTS = N_KEYS * N_KEYS
PEER_TOPK = 16
PEER_BLOCK = 256
NORM_EPS = 1e-6

kernel_name = "hymba_gla_gdn_peer_stream_step"


def rms_norm(x, w):
    xf = x.astype(jnp.float32)
    y = xf * lax.rsqrt(jnp.mean(xf * xf, axis=-1, keepdims=True) + NORM_EPS)
    return (y * w.astype(jnp.float32)).astype(x.dtype)


def l2_norm(x):
    xf = x.astype(jnp.float32)
    return (xf * lax.rsqrt(jnp.sum(xf * xf, axis=-1, keepdims=True) + NORM_EPS)).astype(x.dtype)


def _split_cols(x, sizes):
    idx, acc = [], 0
    for s in sizes[:-1]:
        acc += s
        idx.append(acc)
    return jnp.split(x, idx, axis=-1)


def _to_chunks(x):
    b, l = x.shape[:2]
    n = -(-l // CHUNK)
    x = jnp.pad(x, [(0, 0), (0, n * CHUNK - l)] + [(0, 0)] * (x.ndim - 2))
    x = x.reshape((b, n, CHUNK) + x.shape[2:])
    return jnp.moveaxis(x, (1, 2), (0, 3))


def _from_chunks(x, l):
    x = jnp.moveaxis(x, (0, 3), (1, 2))
    n, c = x.shape[1], x.shape[2]
    x = x.reshape((x.shape[0], n * c) + x.shape[3:])
    return x[:, :l]


def _gla_scan(q, k, v, log_a, s0):
    l = q.shape[1]
    xs = tuple(_to_chunks(t.astype(jnp.float32)) for t in (q, k, v, log_a))
    tril = jnp.tril(jnp.ones((CHUNK, CHUNK), dtype=bool))[:, :, None]

    def step(S, inp):
        qc, kc, vc, ac = inp
        G = jnp.cumsum(ac, axis=2)
        rel = G[:, :, :, None, :] - G[:, :, None, :, :]
        dec = jnp.where(tril, jnp.exp(jnp.where(tril, rel, 0.0)), 0.0)
        att = jnp.sum(qc[:, :, :, None, :] * kc[:, :, None, :, :] * dec, axis=-1)
        o = (jnp.einsum('bhcd,bhde->bhce', qc * jnp.exp(G), S)
             + jnp.einsum('bhij,bhje->bhie', att, vc))
        g_last = G[:, :, -1:, :]
        S = (S * jnp.exp(g_last[:, :, 0, :, None])
             + jnp.einsum('bhjd,bhje->bhde', kc * jnp.exp(g_last - G), vc))
        return S, o

    s_fin, o = lax.scan(step, s0.astype(jnp.float32), xs)
    return _from_chunks(o, l).astype(q.dtype), s_fin.astype(s0.dtype)


def _gdn_scan(q, k, v, log_a, beta, s0):
    l = q.shape[1]
    dv = v.shape[-1]
    xs = tuple(_to_chunks(t.astype(jnp.float32)) for t in (q, k, v, log_a, beta))
    tril = jnp.tril(jnp.ones((CHUNK, CHUNK), dtype=bool))
    strict = jnp.tril(jnp.ones((CHUNK, CHUNK), dtype=bool), k=-1)
    eye = jnp.eye(CHUNK, dtype=jnp.float32)

    def step(S, inp):
        qc, kc, vc, ac, bc = inp
        G = jnp.cumsum(ac, axis=-1)
        rel = G[..., :, None] - G[..., None, :]
        dec = jnp.where(tril, jnp.exp(jnp.where(tril, rel, 0.0)), 0.0)
        kk = jnp.einsum('bhid,bhjd->bhij', kc, kc)
        low = jnp.where(strict, bc[..., :, None] * kk * dec, 0.0)
        rhs = jnp.concatenate([vc * bc[..., None], kc * (bc * jnp.exp(G))[..., None]], axis=-1)
        sol = lax.linalg.triangular_solve(eye + low, rhs, left_side=True, lower=True,
                                          unit_diagonal=True)
        u_c, w_c = sol[..., :dv], sol[..., dv:]
        v_new = u_c - jnp.einsum('bhcd,bhde->bhce', w_c, S)
        qk = jnp.einsum('bhid,bhjd->bhij', qc, kc) * dec
        o = (jnp.einsum('bhcd,bhde->bhce', qc * jnp.exp(G)[..., None], S)
             + jnp.einsum('bhij,bhje->bhie', qk, v_new))
        g_last = G[..., -1:]
        S = (S * jnp.exp(g_last)[..., None]
             + jnp.einsum('bhjd,bhje->bhde', kc * jnp.exp(g_last - G)[..., None], v_new))
        return S, o

    s_fin, o = lax.scan(step, s0.astype(jnp.float32), xs)
    return _from_chunks(o, l).astype(q.dtype), s_fin.astype(s0.dtype)


def _peer(h, peer_wq, peer_k1, peer_k2, peer_u, peer_v):
    b, l, d = h.shape
    t = b * l
    nb = -(-t // PEER_BLOCK)
    xt = jnp.pad(h.reshape(t, d), ((0, nb * PEER_BLOCK - t), (0, 0)))
    xb = xt.reshape(nb, PEER_BLOCK, d)

    def block(xblk):
        q = (xblk @ peer_wq).reshape(PEER_BLOCK, PEER_HEADS, PEER_QDIM)
        s1 = jnp.einsum('thd,hnd->thn', q[..., :PEER_HALF], peer_k1)
        s2 = jnp.einsum('thd,hnd->thn', q[..., PEER_HALF:], peer_k2)
        v1, i1 = lax.top_k(s1, PEER_TOPK)
        v2, i2 = lax.top_k(s2, PEER_TOPK)
        cand = (v1[..., :, None] + v2[..., None, :]).reshape(PEER_BLOCK, PEER_HEADS, PEER_TOPK * PEER_TOPK)
        cidx = (i1[..., :, None] * N_KEYS + i2[..., None, :]).reshape(PEER_BLOCK, PEER_HEADS, PEER_TOPK * PEER_TOPK)
        sc, pos = lax.top_k(cand, PEER_TOPK)
        eidx = jnp.take_along_axis(cidx, pos, axis=-1)
        gate = jax.nn.softmax(sc.astype(jnp.float32), axis=-1)
        act = jax.nn.gelu(jnp.einsum('thkd,td->thk', peer_u[eidx], xblk))
        wgt = (gate * act.astype(jnp.float32)).astype(xblk.dtype)
        return jnp.einsum('thk,thkd->td', wgt, peer_v[eidx])

    yb = lax.map(block, xb)
    return yb.reshape(nb * PEER_BLOCK, d)[:t].reshape(b, l, d)


def _layer(x, s_gla, s_gdn, conv_buf, norm_mix_w, w_in, gla_w_gk2, gla_b_gk, gla_norm_w,
           gdn_conv_w, gdn_a_log, gdn_dt_bias, gdn_norm_w, w_out, norm_ffn_w,
           peer_wq, peer_k1, peer_k2, peer_u, peer_v):
    b, l, _ = x.shape
    h = rms_norm(x, norm_mix_w)
    proj = h @ w_in
    gq, gk, gv, glr, gg, dqkv, da, db, dz = _split_cols(proj, IN_SIZES)

    q1 = gq.reshape(b, l, GLA_HEADS, GLA_DK) * (GLA_DK ** -0.5)
    k1 = gk.reshape(b, l, GLA_HEADS, GLA_DK)
    v1 = gv.reshape(b, l, GLA_HEADS, GLA_DV)
    log_a1 = jax.nn.log_sigmoid((glr @ gla_w_gk2 + gla_b_gk).astype(jnp.float32)) / GLA_GATE_TAU
    log_a1 = log_a1.reshape(b, l, GLA_HEADS, GLA_DK)
    o1, s_gla_new = _gla_scan(q1, k1, v1, log_a1, s_gla)
    o1 = rms_norm(o1, gla_norm_w) * jax.nn.silu(gg).reshape(b, l, GLA_HEADS, GLA_DV)

    conv_in = jnp.concatenate([conv_buf.astype(dqkv.dtype), dqkv], axis=1)
    conv = conv_in[:, 0:l] * gdn_conv_w[0]
    for i in range(1, CONV_W):
        conv = conv + conv_in[:, i:i + l] * gdn_conv_w[i]
    conv = jax.nn.silu(conv)
    new_buf = conv_in[:, -(CONV_W - 1):]
    cq, ck, cv = _split_cols(conv, (GDN_QK, GDN_QK, GDN_V))
    q2 = l2_norm(cq.reshape(b, l, GDN_HEADS, GDN_DK)) * (GDN_DK ** -0.5)
    k2 = l2_norm(ck.reshape(b, l, GDN_HEADS, GDN_DK))
    v2 = cv.reshape(b, l, GDN_HEADS, GDN_DV)
    beta = jax.nn.sigmoid(db.astype(jnp.float32))
    log_a2 = -jnp.exp(gdn_a_log.astype(jnp.float32)) * jax.nn.softplus((da + gdn_dt_bias).astype(jnp.float32))
    o2, s_gdn_new = _gdn_scan(q2, k2, v2, log_a2, beta, s_gdn)
    o2 = rms_norm(o2, gdn_norm_w) * jax.nn.silu(dz).reshape(b, l, GDN_HEADS, GDN_DV)

    mix = jnp.concatenate([o1.reshape(b, l, GLA_V), o2.reshape(b, l, GDN_V)], axis=-1) @ w_out
    x = x + mix
    x = x + _peer(rms_norm(x, norm_ffn_w), peer_wq, peer_k1, peer_k2, peer_u, peer_v)
    return x, s_gla_new, s_gdn_new, new_buf


def setup_inputs(seed: int = 0) -> dict:
    key = jax.random.key(seed)
    ks = jax.random.split(key, 24)
    f32 = jnp.float32
    nrm = lambda k, shape, scale: jax.random.normal(k, shape, f32) * scale
    dt = jnp.exp(jax.random.uniform(ks[12], (DEPTH, GDN_HEADS), f32, math.log(1e-3), math.log(1e-1)))
    return {
        "x_prompt": nrm(ks[0], (BATCH, SEQ, D_MODEL), 1.0),
        "x_sample": nrm(ks[1], (DEC_BATCH, DEC_SEQ, D_MODEL), 1.0),
        "state_gla": nrm(ks[2], (DEPTH, DEC_BATCH, GLA_HEADS, GLA_DK, GLA_DV), 0.1),
        "state_gdn": nrm(ks[3], (DEPTH, DEC_BATCH, GDN_HEADS, GDN_DK, GDN_DV), 0.1),
        "state_gdn_conv": nrm(ks[4], (DEPTH, DEC_BATCH, CONV_W - 1, GDN_QKV), 1.0),
        "norm_mix_w": 1.0 + nrm(ks[5], (DEPTH, D_MODEL), 0.02),
        "w_in": nrm(ks[6], (DEPTH, D_MODEL, N_IN), D_MODEL ** -0.5),
        "gla_w_gk2": nrm(ks[7], (DEPTH, GLA_LR, GLA_QK), GLA_LR ** -0.5),
        "gla_b_gk": nrm(ks[8], (DEPTH, GLA_QK), 0.1),
        "gla_norm_w": 1.0 + nrm(ks[9], (DEPTH, GLA_DV), 0.02),
        "gdn_conv_w": nrm(ks[10], (DEPTH, CONV_W, GDN_QKV), CONV_W ** -0.5),
        "gdn_a_log": jnp.log(jax.random.uniform(ks[11], (DEPTH, GDN_HEADS), f32, 1.0, 16.0)),
        "gdn_dt_bias": jnp.log(jnp.expm1(dt)),
        "gdn_norm_w": 1.0 + nrm(ks[13], (DEPTH, GDN_DV), 0.02),
        "w_out": nrm(ks[14], (DEPTH, D_MIX, D_MODEL), D_MIX ** -0.5),
        "norm_ffn_w": 1.0 + nrm(ks[15], (DEPTH, D_MODEL), 0.02),
        "peer_wq": nrm(ks[16], (DEPTH, D_MODEL, PEER_HEADS * PEER_QDIM), D_MODEL ** -0.5),
        "peer_k1": nrm(ks[17], (DEPTH, PEER_HEADS, N_KEYS, PEER_HALF), PEER_HALF ** -0.5),
        "peer_k2": nrm(ks[18], (DEPTH, PEER_HEADS, N_KEYS, PEER_HALF), PEER_HALF ** -0.5),
        "peer_u": nrm(ks[19], (DEPTH, N_EXPERTS, D_MODEL), D_MODEL ** -0.5),
        "peer_v": nrm(ks[20], (DEPTH, N_EXPERTS, D_MODEL), D_MODEL ** -0.5),
        "norm_final_w": 1.0 + nrm(ks[21], (D_MODEL,), 0.02),
    }


def reference(x_prompt, x_sample, state_gla, state_gdn, state_gdn_conv, norm_mix_w, w_in,
              gla_w_gk2, gla_b_gk, gla_norm_w, gdn_conv_w, gdn_a_log, gdn_dt_bias, gdn_norm_w,
              w_out, norm_ffn_w, peer_wq, peer_k1, peer_k2, peer_u, peer_v, norm_final_w):
    yp, ys = x_prompt, x_sample
    gla_p, gdn_p, conv_p, gla_s, gdn_s, conv_s = [], [], [], [], [], []
    for l in range(DEPTH):
        lw = (norm_mix_w[l], w_in[l], gla_w_gk2[l], gla_b_gk[l], gla_norm_w[l], gdn_conv_w[l],
              gdn_a_log[l], gdn_dt_bias[l], gdn_norm_w[l], w_out[l], norm_ffn_w[l],
              peer_wq[l], peer_k1[l], peer_k2[l], peer_u[l], peer_v[l])
        z_gla = jnp.zeros((BATCH, GLA_HEADS, GLA_DK, GLA_DV), x_prompt.dtype)
        z_gdn = jnp.zeros((BATCH, GDN_HEADS, GDN_DK, GDN_DV), x_prompt.dtype)
        z_conv = jnp.zeros((BATCH, CONV_W - 1, GDN_QKV), x_prompt.dtype)
        yp, a, b_, c = _layer(yp, z_gla, z_gdn, z_conv, *lw)
        gla_p.append(a); gdn_p.append(b_); conv_p.append(c)
        ys, a, b_, c = _layer(ys, state_gla[l], state_gdn[l], state_gdn_conv[l], *lw)
        gla_s.append(a); gdn_s.append(b_); conv_s.append(c)
    y_prompt = rms_norm(yp, norm_final_w)
    y_sample = rms_norm(ys, norm_final_w)
    return (y_prompt, y_sample, jnp.stack(gla_p), jnp.stack(gdn_p), jnp.stack(conv_p),
            jnp.stack(gla_s), jnp.stack(gdn_s), jnp.stack(conv_s))
```

```cpp
#include <hip/hip_runtime.h>
#include <hip/hip_cooperative_groups.h>
#include <cstdio>
#include <cstdint>
namespace cg = cooperative_groups;

#define DI __device__ __forceinline__
typedef unsigned short u16;
typedef short bf16x8 __attribute__((ext_vector_type(8)));
typedef float f32x16 __attribute__((ext_vector_type(16)));
typedef float f32x2 __attribute__((ext_vector_type(2)));
typedef __bf16 bf16x2_t __attribute__((ext_vector_type(2)));
typedef unsigned u32x4 __attribute__((ext_vector_type(4)));

#ifndef REP_P0
#define REP_P0 1
#endif
#ifndef REP_P1
#define REP_P1 1
#endif
#ifndef REP_P2G
#define REP_P2G 1
#endif
#ifndef REP_P2L
#define REP_P2L 1
#endif
#ifndef REP_P3G
#define REP_P3G 1
#endif
#ifndef REP_P4A
#define REP_P4A 1
#endif
#ifndef REP_P4B
#define REP_P4B 1
#endif
#ifndef REP_P5
#define REP_P5 1
#endif
#ifndef REP_P6
#define REP_P6 1
#endif
#ifndef REP_P8
#define REP_P8 1
#endif
#ifndef REP_P7
#define REP_P7 1
#endif
constexpr int NTHR = 512;
constexpr int T_ALL = 33280, T_P = 32768;
constexpr int NCH = 2112;
constexpr size_t LDS_BYTES = 147456;

constexpr size_t OFF_WIN = 0;
constexpr size_t OFF_WOUT = OFF_WIN + 3840ull * 1024 * 2;
constexpr size_t OFF_WQ = OFF_WOUT + 1024ull * 1024 * 2;
constexpr size_t OFF_K12 = OFF_WQ + 2048ull * 1024 * 2;
constexpr size_t OFF_R1 = OFF_K12 + 2ull * 8 * 128 * 128 * 2;
constexpr size_t OFF_R2 = OFF_R1 + (size_t)T_ALL * 1024 * 2;
constexpr size_t OFF_PGLA = OFF_R2;
constexpr size_t OFF_PGATE = OFF_PGLA + (size_t)T_ALL * 1024 * 2;
constexpr size_t OFF_PGDN = OFF_PGATE + (size_t)T_ALL * 1024 * 2;
constexpr size_t OFF_R3 = OFF_PGDN + (size_t)T_ALL * 1536 * 2;
constexpr size_t OFF_GI = OFF_R3;
constexpr size_t OFF_GDEC = OFF_GI + (size_t)NCH * 98304;
constexpr size_t OFF_BAR = (OFF_GDEC + NCH * 4 + 255) / 256 * 256;
constexpr size_t OFF_RSS = OFF_BAR + 14080;
constexpr size_t WS_NEED = OFF_RSS + (size_t)T_ALL * 4;
constexpr size_t OFF_QP = OFF_R2;
constexpr size_t OFF_EIDX = OFF_PGDN;
constexpr size_t OFF_GATE = OFF_EIDX + (size_t)T_ALL * 128 * 4;
constexpr size_t OFF_O = OFF_PGDN;
constexpr size_t OFF_UB = OFF_R1 + (size_t)T_ALL * 512 * 2;
constexpr size_t OFF_H2 = OFF_R3 + 64ull * 1048576;
constexpr size_t OFF_VB = OFF_UB + 16384ull * 1024;
constexpr size_t OFF_USC = OFF_VB + 16384ull * 1024;
constexpr size_t OFF_VSC = OFF_USC + 16384ull * 4;
constexpr size_t OOFF_GB = 0;
constexpr size_t OOFF_GLD = OOFF_GB + (size_t)NCH * 8192;
constexpr size_t OOFF_PSMALL = OOFF_GLD + (size_t)NCH * 64;
constexpr size_t OUT_Y = 0;
constexpr size_t OUT_GLA_P = (size_t)T_ALL * 1024;
constexpr size_t OUT_GDN_P = OUT_GLA_P + 4 * 4 * 64 * 128;
constexpr size_t OUT_CONV_P = OUT_GDN_P + 4 * 4 * 128 * 128;
constexpr size_t OUT_GLA_S = OUT_CONV_P + 4 * 3 * 1536;
constexpr size_t OUT_GDN_S = OUT_GLA_S + 16 * 4 * 64 * 128;
constexpr size_t OUT_CONV_S = OUT_GDN_S + 16 * 4 * 128 * 128;

struct Params {
  const float *x_prompt, *x_sample, *state_gla, *state_gdn, *state_conv, *norm_mix_w, *w_in, *gla_w_gk2, *gla_b_gk,
      *gla_norm_w, *gdn_conv_w, *gdn_a_log, *gdn_dt_bias, *gdn_norm_w, *w_out, *norm_ffn_w, *peer_wq, *peer_k1, *peer_k2,
      *peer_u, *peer_v, *norm_final_w;
  float* out;
  char* ws;
};

DI unsigned pk2(float a, float b) { f32x2 v = {a, b}; bf16x2_t r = __builtin_convertvector(v, bf16x2_t); return __builtin_bit_cast(unsigned, r); }
DI u16 f2bf(float a) { return (u16)(pk2(a, 0.f) & 0xffffu); }
DI float bf2f(u16 v) { return __uint_as_float(((unsigned)v) << 16); }
DI float bflo(unsigned v) { return __uint_as_float(v << 16); }
DI float bfhi(unsigned v) { return __uint_as_float(v & 0xffff0000u); }
DI int crow(int reg, int h) { return (reg & 3) + 8 * (reg >> 2) + 4 * h; }
DI float wave_sum(float v) {
#pragma unroll
  for (int o = 32; o > 0; o >>= 1) v += __shfl_xor(v, o);
  return v;
}
DI float sigmoidf_(float x) { return __builtin_amdgcn_rcpf(1.f + __expf(-x)); }
DI float softplusf_(float x) { return x > 20.f ? x : log1pf(__expf(x)); }
DI const float* xrow(const Params& p, int tok) { return tok < T_P ? p.x_prompt + (size_t)tok * 1024 : p.x_sample + (size_t)(tok - T_P) * 1024; }
DI bf16x8 pack8(const f32x16& x, int s) {
  u32x4 q;
  q.x = pk2(x[8 * s + 0], x[8 * s + 1]); q.y = pk2(x[8 * s + 2], x[8 * s + 3]);
  q.z = pk2(x[8 * s + 4], x[8 * s + 5]); q.w = pk2(x[8 * s + 6], x[8 * s + 7]);
  return __builtin_bit_cast(bf16x8, q);
}
#define LDS_BARRIER() do { asm volatile("s_waitcnt lgkmcnt(0)" ::: "memory"); __builtin_amdgcn_s_barrier(); asm volatile("" ::: "memory"); } while (0)
#define MFMA(a, b, c) __builtin_amdgcn_mfma_f32_32x32x16_bf16((a), (b), (c), 0, 0, 0)

template <int KSTEPS, class FA, class FB>
DI void mma_tile(f32x16& acc, FA fa, FB fb, int r, int h) {
#pragma unroll
  for (int s = 0; s < KSTEPS; ++s) {
    bf16x8 a, b;
#pragma unroll
    for (int j = 0; j < 8; ++j) {
      const int k = 16 * s + 8 * h + j;
      a[j] = (short)fa(r, k);
      b[j] = (short)fb(k, r);
    }
    acc = MFMA(a, b, acc);
  }
}

template <int KSTEPS>
DI void mma_tile_vec(f32x16& acc, const u16* A, int lda, const u16* B, int ldb, int r, int h) {
#pragma unroll
  for (int s = 0; s < KSTEPS; ++s) {
    const bf16x8 a = *(const bf16x8*)(A + r * lda + 16 * s + 8 * h);
    const bf16x8 b = *(const bf16x8*)(B + r * ldb + 16 * s + 8 * h);
    acc = MFMA(a, b, acc);
  }
}

DI void unpack16(const uint4& a, const uint4& b, float* f) {
  f[0] = bflo(a.x); f[1] = bfhi(a.x); f[2] = bflo(a.y); f[3] = bfhi(a.y); f[4] = bflo(a.z); f[5] = bfhi(a.z); f[6] = bflo(a.w); f[7] = bfhi(a.w);
  f[8] = bflo(b.x); f[9] = bfhi(b.x); f[10] = bflo(b.y); f[11] = bfhi(b.y); f[12] = bflo(b.z); f[13] = bfhi(b.z); f[14] = bflo(b.w); f[15] = bfhi(b.w);
}

DI int win_orig_col(int n) {
  if (n < 1024) return n;
  if (n < 1536) return 1040 + (n - 1024);
  if (n < 2048) return 3096 + (n - 1536);
  if (n < 3584) return 1552 + (n - 2048);
  if (n < 3600) return 1024 + (n - 3584);
  if (n < 3604) return 3088 + (n - 3600);
  if (n < 3608) return 3092 + (n - 3604);
  return -1;
}

DI void transpose_w(const float* __restrict__ w, int ncols_src, int n_dst, bool permute, u16* __restrict__ dst, int gtid, int gn) {
  const int items = n_dst * 128;
  for (int it = gtid; it < items; it += gn) {
    const int n = it % n_dst, kg = it / n_dst;
    const int oc = permute ? win_orig_col(n) : n;
    unsigned q[4];
#pragma unroll
    for (int j = 0; j < 4; ++j) {
      float a = 0.f, b = 0.f;
      if (oc >= 0) { a = w[(size_t)(kg * 8 + 2 * j) * ncols_src + oc]; b = w[(size_t)(kg * 8 + 2 * j + 1) * ncols_src + oc]; }
      q[j] = pk2(a, b);
    }
    *(uint4*)(dst + (size_t)n * 1024 + kg * 8) = make_uint4(q[0], q[1], q[2], q[3]);
  }
}

template <class RowF>
DI void norm_rows(RowF rowf, const float* __restrict__ w, u16* __restrict__ dst) {
  const int lane = threadIdx.x & 63;
  const int gw = blockIdx.x * (NTHR / 64) + (threadIdx.x >> 6), nw = gridDim.x * (NTHR / 64);
  float4 ww[4];
#pragma unroll
  for (int q = 0; q < 4; ++q) ww[q] = ((const float4*)w)[lane + 64 * q];
  for (int tok = gw; tok < T_ALL; tok += 2 * nw) {
    const int tok2 = tok + nw;
    const bool has2 = tok2 < T_ALL;
    const float4* xr = (const float4*)rowf(tok);
    const float4* xr2 = (const float4*)rowf(has2 ? tok2 : tok);
    float4 v[4], v2[4];
    float ss = 0.f, ss2 = 0.f;
#pragma unroll
    for (int q = 0; q < 4; ++q) { v[q] = xr[lane + 64 * q]; v2[q] = xr2[lane + 64 * q]; }
#pragma unroll
    for (int q = 0; q < 4; ++q) {
      ss += v[q].x * v[q].x + v[q].y * v[q].y + v[q].z * v[q].z + v[q].w * v[q].w;
      ss2 += v2[q].x * v2[q].x + v2[q].y * v2[q].y + v2[q].z * v2[q].z + v2[q].w * v2[q].w;
    }
#pragma unroll
    for (int o = 32; o > 0; o >>= 1) { ss += __shfl_xor(ss, o); ss2 += __shfl_xor(ss2, o); }
    const float rs = rsqrtf(ss * (1.f / 1024.f) + 1e-6f), rs2 = rsqrtf(ss2 * (1.f / 1024.f) + 1e-6f);
#pragma unroll
    for (int q = 0; q < 4; ++q) {
      uint2 o;
      o.x = pk2(v[q].x * rs * ww[q].x, v[q].y * rs * ww[q].y);
      o.y = pk2(v[q].z * rs * ww[q].z, v[q].w * rs * ww[q].w);
      *(uint2*)(dst + (size_t)tok * 1024 + 4 * (lane + 64 * q)) = o;
      if (has2) {
        uint2 o2;
        o2.x = pk2(v2[q].x * rs2 * ww[q].x, v2[q].y * rs2 * ww[q].y);
        o2.y = pk2(v2[q].z * rs2 * ww[q].z, v2[q].w * rs2 * ww[q].w);
        *(uint2*)(dst + (size_t)tok2 * 1024 + 4 * (lane + 64 * q)) = o2;
      }
    }
  }
}

DI void convert_f32_bf16(const float* __restrict__ src, u16* __restrict__ dst, size_t n4, int gtid, int gn) {
  for (size_t i = gtid; i < n4; i += gn) {
    const float4 v = ((const float4*)src)[i];
    uint2 o; o.x = pk2(v.x, v.y); o.y = pk2(v.z, v.w);
    ((uint2*)dst)[i] = o;
  }
}

DI void convert_rows_fp8(const float* __restrict__ src, unsigned char* __restrict__ dst, float* __restrict__ sc, int gw, int nw) {
  const int lane = threadIdx.x & 63;
  for (int row = gw; row < 16384; row += nw) {
    const float4* rp = (const float4*)(src + (size_t)row * 1024 + lane * 16);
    float4 v[4];
    float am = 0.f;
#pragma unroll
    for (int q = 0; q < 4; ++q) { v[q] = rp[q]; am = fmaxf(am, fmaxf(fmaxf(fabsf(v[q].x), fabsf(v[q].y)), fmaxf(fabsf(v[q].z), fabsf(v[q].w)))); }
#pragma unroll
    for (int o = 32; o > 0; o >>= 1) am = fmaxf(am, __shfl_xor(am, o));
    const float s = am > 0.f ? 256.f / am : 1.f;
    unsigned w[4];
#pragma unroll
    for (int q = 0; q < 4; ++q) {
      int t = 0;
      t = __builtin_amdgcn_cvt_pk_fp8_f32(v[q].x * s, v[q].y * s, t, false);
      t = __builtin_amdgcn_cvt_pk_fp8_f32(v[q].z * s, v[q].w * s, t, true);
      w[q] = (unsigned)t;
    }
    *(uint4*)(dst + (size_t)row * 1024 + lane * 16) = make_uint4(w[0], w[1], w[2], w[3]);
    if (lane == 0) sc[row] = am > 0.f ? am * (1.f / 256.f) : 1.f;
  }
}

DI void phase0(const Params& p) {
  const int gtid = blockIdx.x * NTHR + threadIdx.x, gn = gridDim.x * NTHR;
  transpose_w(p.w_in, 3608, 3840, true, (u16*)(p.ws + OFF_WIN), gtid, gn);
  transpose_w(p.w_out, 1024, 1024, false, (u16*)(p.ws + OFF_WOUT), gtid, gn);
  transpose_w(p.peer_wq, 2048, 2048, false, (u16*)(p.ws + OFF_WQ), gtid, gn);
  convert_f32_bf16(p.peer_k1, (u16*)(p.ws + OFF_K12), 8 * 128 * 128 / 4, gtid, gn);
  convert_f32_bf16(p.peer_k2, (u16*)(p.ws + OFF_K12) + 8 * 128 * 128, 8 * 128 * 128 / 4, gtid, gn);
  norm_rows([&](int tok) { return xrow(p, tok); }, p.norm_mix_w, (u16*)(p.ws + OFF_R1));
}

template <int LD>
DI void store_tile_bf16(u16* ptr, const f32x16 (&acc)[2][2]) {
#pragma unroll
  for (int mi = 0; mi < 2; ++mi)
#pragma unroll
    for (int g = 0; g < 4; ++g) {
#pragma unroll
      for (int j = 0; j < 4; ++j) {
        u16* q = ptr + (size_t)(mi * 32 + 8 * g + j) * LD;
        asm volatile("" : "+v"(q));
        q[0] = f2bf(acc[mi][0][4 * g + j]);
        q[32] = f2bf(acc[mi][1][4 * g + j]);
      }
    }
}

template <class Epi>
DI void gemm_phase(const u16* __restrict__ A, const u16* __restrict__ Bt, int N, Epi epi, char* smem) {
  constexpr int LS = 72;
  u16* sA0 = (u16*)smem;
  u16* sB0 = sA0 + 256 * LS;
  u16* sA1 = sB0 + 128 * LS;
  u16* sB1 = sA1 + 256 * LS;
  const int tid = threadIdx.x, lane = tid & 63, wid = tid >> 6, r = lane & 31, h = lane >> 5;
  const int wm = wid >> 1, wn = wid & 1;
  const int NTN = N / 128;
  const int ntiles = 130 * NTN;
  const int xcd = blockIdx.x & 7, cu = blockIdx.x >> 3, ncu = gridDim.x >> 3;
  auto tile_ptrs = [&](int tile, int& mt, int& nt) {
    const int grp = tile / (4 * NTN), idg = tile % (4 * NTN);
    const int gsz = (130 - grp * 4) < 4 ? (130 - grp * 4) : 4;
    mt = grp * 4 + idg % gsz; nt = idg / gsz;
  };
  uint4 p0, p1, p2, p3, p4, p5, q0, q1, q2, q3, q4, q5;
  const int so = (tid >> 3) * LS + (tid & 7) * 8;
  const size_t toff = (size_t)(tid >> 3) * 1024 + (tid & 7) * 8;
  bool first = true;
  for (int base = xcd * ncu; base < ntiles; base += 8 * ncu) {
    const int tile = base + cu;
    if (tile >= ntiles) break;
    int mt, nt, mtn, ntn;
    tile_ptrs(tile, mt, nt);
    const int tnext = (tile + 8 * ncu < ntiles) ? tile + 8 * ncu : tile;
    tile_ptrs(tnext, mtn, ntn);
    const u16* gA = A + (size_t)mt * 256 * 1024 + toff;
    const u16* gB = Bt + (size_t)nt * 128 * 1024 + toff;
    const u16* gAn = A + (size_t)mtn * 256 * 1024 + toff;
    const u16* gBn = Bt + (size_t)ntn * 128 * 1024 + toff;
    f32x16 acc[2][2];
#pragma unroll
    for (int a = 0; a < 2; ++a)
#pragma unroll
      for (int b = 0; b < 2; ++b)
#pragma unroll
        for (int i = 0; i < 16; ++i) acc[a][b][i] = 0.f;
#define GLOAD(a0, a1, a2, a3, b0, b1, pA, pB, kt)                                                          \
  {                                                                                                        \
    a0 = *(const uint4*)(pA + (kt) * 64); a1 = *(const uint4*)(pA + (kt) * 64 + 64 * 1024);                \
    a2 = *(const uint4*)(pA + (kt) * 64 + 128 * 1024); a3 = *(const uint4*)(pA + (kt) * 64 + 192 * 1024);  \
    b0 = *(const uint4*)(pB + (kt) * 64); b1 = *(const uint4*)(pB + (kt) * 64 + 64 * 1024);                \
  }
#define SSTORE(a0, a1, a2, a3, b0, b1, sA, sB)                                                             \
  {                                                                                                        \
    *(uint4*)((sA) + so) = a0; *(uint4*)((sA) + so + 64 * LS) = a1; *(uint4*)((sA) + so + 128 * LS) = a2;  \
    *(uint4*)((sA) + so + 192 * LS) = a3; *(uint4*)((sB) + so) = b0; *(uint4*)((sB) + so + 64 * LS) = b1;  \
  }
#define LDFR(fa, fb, cA, cB, ks)                                                                          \
  {                                                                                                        \
    _Pragma("unroll") for (int mi = 0; mi < 2; ++mi) fa[mi] = *(const bf16x8*)((cA) + (wm * 64 + mi * 32 + r) * LS + (ks) * 16 + h * 8); \
    _Pragma("unroll") for (int ni = 0; ni < 2; ++ni) fb[ni] = *(const bf16x8*)((cB) + (wn * 64 + ni * 32 + r) * LS + (ks) * 16 + h * 8); \
  }
#define MMA4(fa, fb)                                                                                       \
  {                                                                                                        \
    _Pragma("unroll") for (int mi = 0; mi < 2; ++mi)                                                       \
      _Pragma("unroll") for (int ni = 0; ni < 2; ++ni) acc[mi][ni] = MFMA(fa[mi], fb[ni], acc[mi][ni]);    \
  }
#define COMPUTE(cA, cB, x0, x1, x2, x3, x4, x5, oA, oB)                                                    \
  {                                                                                                        \
    bf16x8 fa0[2], fb0[2], fa1[2], fb1[2];                                                                 \
    LDFR(fa0, fb0, cA, cB, 0);                                                                             \
    LDFR(fa1, fb1, cA, cB, 1); __builtin_amdgcn_sched_barrier(0);                                          \
    *(uint4*)((oA) + so) = x0; *(uint4*)((oA) + so + 64 * LS) = x1;                                        \
    MMA4(fa0, fb0); __builtin_amdgcn_sched_barrier(0);                                                     \
    LDFR(fa0, fb0, cA, cB, 2);                                                                             \
    *(uint4*)((oA) + so + 128 * LS) = x2; *(uint4*)((oA) + so + 192 * LS) = x3; __builtin_amdgcn_sched_barrier(0); \
    MMA4(fa1, fb1); __builtin_amdgcn_sched_barrier(0);                                                     \
    LDFR(fa1, fb1, cA, cB, 3);                                                                             \
    *(uint4*)((oB) + so) = x4; *(uint4*)((oB) + so + 64 * LS) = x5; __builtin_amdgcn_sched_barrier(0);     \
    MMA4(fa0, fb0); __builtin_amdgcn_sched_barrier(0);                                                     \
    MMA4(fa1, fb1);                                                                                        \
  }
    if (first) {
      GLOAD(p0, p1, p2, p3, p4, p5, gA, gB, 0);
      GLOAD(q0, q1, q2, q3, q4, q5, gA, gB, 1);
      SSTORE(p0, p1, p2, p3, p4, p5, sA0, sB0);
      LDS_BARRIER();
      first = false;
    }
#pragma unroll 1
    for (int kt = 0; kt < 16; kt += 2) {
      const u16* sa = (kt < 14) ? gA : gAn;
      const u16* sb = (kt < 14) ? gB : gBn;
      const int k2 = (kt + 2) & 15;
      GLOAD(p0, p1, p2, p3, p4, p5, sa, sb, k2);
      __builtin_amdgcn_sched_barrier(0);
      COMPUTE(sA0, sB0, q0, q1, q2, q3, q4, q5, sA1, sB1);
      LDS_BARRIER();
      GLOAD(q0, q1, q2, q3, q4, q5, sa, sb, k2 + 1);
      __builtin_amdgcn_sched_barrier(0);
      COMPUTE(sA1, sB1, p0, p1, p2, p3, p4, p5, sA0, sB0);
      LDS_BARRIER();
    }
#undef COMPUTE
#undef LDFR
#undef MMA4
#undef GLOAD
#undef SSTORE
    epi(mt * 256 + wm * 64 + 4 * h, nt * 128 + wn * 64 + r, acc);
  }
}

template <int LD>
DI void store_tile4_bf16(u16* ptr, const f32x16 (&acc)[4][2]) {
#pragma unroll
  for (int mi = 0; mi < 4; ++mi)
#pragma unroll
    for (int g = 0; g < 4; ++g) {
#pragma unroll
      for (int j = 0; j < 4; ++j) {
        u16* q = ptr + (size_t)(mi * 32 + 8 * g + j) * LD;
        asm volatile("" : "+v"(q));
        q[0] = f2bf(acc[mi][0][4 * g + j]);
        q[32] = f2bf(acc[mi][1][4 * g + j]);
      }
    }
}
DI void gemm_in_phase(const Params& p, char* smem) {
  constexpr int LS = 72, NTN = 15, NTM = 130, GM = 4;
  u16* sA0 = (u16*)smem;
  u16* sB0 = sA0 + 256 * LS;
  u16* sA1 = sB0 + 256 * LS;
  u16* sB1 = sA1 + 256 * LS;
  const int tid = threadIdx.x, lane = tid & 63, wid = tid >> 6, r = lane & 31, h = lane >> 5;
  const int wm = wid >> 2, wn = wid & 3;
  const u16* A = (const u16*)(p.ws + OFF_R1);
  const u16* Bt = (const u16*)(p.ws + OFF_WIN);
  const int ntiles = NTM * NTN;
  const int xcd = blockIdx.x & 7, cu = blockIdx.x >> 3, ncu = gridDim.x >> 3;
  for (int base = xcd * ncu; base < ntiles; base += 8 * ncu) {
    const int id = base + cu;
    if (id >= ntiles) break;
    const int grp = id / (GM * NTN), idg = id % (GM * NTN);
    const int gsz = (NTM - grp * GM) < GM ? (NTM - grp * GM) : GM;
    const int mt = grp * GM + idg % gsz, nt = idg / gsz;
    const u16* Ab = A + (size_t)mt * 256 * 1024;
    const u16* Bb = Bt + (size_t)nt * 256 * 1024;
    f32x16 acc[4][2];
#pragma unroll
    for (int a = 0; a < 4; ++a)
#pragma unroll
      for (int b = 0; b < 2; ++b)
#pragma unroll
        for (int i = 0; i < 16; ++i) acc[a][b][i] = 0.f;
    uint4 a0, a1, a2, a3, b0, b1, b2, b3;
    const u16* gA = Ab + (size_t)(tid >> 3) * 1024 + (tid & 7) * 8;
    const u16* gB = Bb + (size_t)(tid >> 3) * 1024 + (tid & 7) * 8;
    const int so = (tid >> 3) * LS + (tid & 7) * 8;
#define GLOAD4(g, x0, x1, x2, x3, kt)                                                                      \
  {                                                                                                        \
    x0 = *(const uint4*)(g + (kt) * 64); x1 = *(const uint4*)(g + (kt) * 64 + 64 * 1024);                  \
    x2 = *(const uint4*)(g + (kt) * 64 + 128 * 1024); x3 = *(const uint4*)(g + (kt) * 64 + 192 * 1024);    \
  }
#define SSTORE4(x0, x1, x2, x3, sX)                                                                        \
  {                                                                                                        \
    *(uint4*)((sX) + so) = x0; *(uint4*)((sX) + so + 64 * LS) = x1; *(uint4*)((sX) + so + 128 * LS) = x2;  \
    *(uint4*)((sX) + so + 192 * LS) = x3;                                                                  \
  }
#define LDFR8(fa, fb, cA, cB, ks)                                                                         \
  {                                                                                                        \
    _Pragma("unroll") for (int mi = 0; mi < 4; ++mi) fa[mi] = *(const bf16x8*)((cA) + (wm * 128 + mi * 32 + r) * LS + (ks) * 16 + h * 8); \
    _Pragma("unroll") for (int ni = 0; ni < 2; ++ni) fb[ni] = *(const bf16x8*)((cB) + (wn * 64 + ni * 32 + r) * LS + (ks) * 16 + h * 8);  \
  }
#define MMA8(fa, fb)                                                                                       \
  {                                                                                                        \
    _Pragma("unroll") for (int mi = 0; mi < 4; ++mi)                                                       \
      _Pragma("unroll") for (int ni = 0; ni < 2; ++ni) acc[mi][ni] = MFMA(fa[mi], fb[ni], acc[mi][ni]);    \
  }
#define COMPUTE8(cA, cB)                                                                                   \
  {                                                                                                        \
    bf16x8 fa0[4], fb0[2], fa1[4], fb1[2];                                                                 \
    LDFR8(fa0, fb0, cA, cB, 0);                                                                            \
    LDFR8(fa1, fb1, cA, cB, 1); __builtin_amdgcn_sched_barrier(0);                                         \
    MMA8(fa0, fb0); __builtin_amdgcn_sched_barrier(0);                                                     \
    LDFR8(fa0, fb0, cA, cB, 2); __builtin_amdgcn_sched_barrier(0);                                         \
    MMA8(fa1, fb1); __builtin_amdgcn_sched_barrier(0);                                                     \
    LDFR8(fa1, fb1, cA, cB, 3); __builtin_amdgcn_sched_barrier(0);                                         \
    MMA8(fa0, fb0); __builtin_amdgcn_sched_barrier(0);                                                     \
    MMA8(fa1, fb1);                                                                                        \
  }
    GLOAD4(gA, a0, a1, a2, a3, 0);
    GLOAD4(gB, b0, b1, b2, b3, 0);
    SSTORE4(a0, a1, a2, a3, sA0);
    SSTORE4(b0, b1, b2, b3, sB0);
    LDS_BARRIER();
#pragma unroll 1
    for (int kt = 0; kt < 16; kt += 2) {
      GLOAD4(gA, a0, a1, a2, a3, kt + 1);
      GLOAD4(gB, b0, b1, b2, b3, kt + 1);
      __builtin_amdgcn_sched_barrier(0);
      COMPUTE8(sA0, sB0);
      SSTORE4(a0, a1, a2, a3, sA1);
      SSTORE4(b0, b1, b2, b3, sB1);
      LDS_BARRIER();
      GLOAD4(gA, a0, a1, a2, a3, kt + 2);
      GLOAD4(gB, b0, b1, b2, b3, kt + 2);
      __builtin_amdgcn_sched_barrier(0);
      COMPUTE8(sA1, sB1);
      SSTORE4(a0, a1, a2, a3, sA0);
      SSTORE4(b0, b1, b2, b3, sB0);
      LDS_BARRIER();
    }
#undef GLOAD4
#undef SSTORE4
#undef COMPUTE8
#undef LDFR8
#undef MMA8
    const int row = mt * 256 + wm * 128 + 4 * h, col = wn * 64 + r;
    if (nt < 4) store_tile4_bf16<1024>((u16*)(p.ws + OFF_PGLA) + (size_t)row * 1024 + nt * 256 + col, acc);
    else if (nt < 8) store_tile4_bf16<1024>((u16*)(p.ws + OFF_PGATE) + (size_t)row * 1024 + (nt - 4) * 256 + col, acc);
    else if (nt < 14) store_tile4_bf16<1536>((u16*)(p.ws + OFF_PGDN) + (size_t)row * 1536 + (nt - 8) * 256 + col, acc);
    else if (wn == 0) {
      float* PSM = p.out + OOFF_PSMALL;
#pragma unroll
      for (int mi = 0; mi < 4; ++mi)
#pragma unroll
        for (int i = 0; i < 16; ++i) PSM[(size_t)(row + mi * 32 + (i & 3) + 8 * (i >> 2)) * 32 + r] = acc[mi][0][i];
    }
  }
}

struct ChunkInfo { int tok0, valid, sample, seq, cl; };
DI ChunkInfo chunk_info(int c) {
  ChunkInfo ci;
  if (c < 512) { ci.tok0 = c * 64; ci.valid = 64; ci.sample = 0; ci.seq = c >> 7; ci.cl = c & 127; }
  else { ci.seq = c - 512; ci.tok0 = T_P + ci.seq * 32; ci.valid = 32; ci.sample = 1; ci.cl = 0; }
  return ci;
}

DI void gdn_prep(const Params& p, int c, int hd, char* smem) {
  constexpr int LD = 136, LT = 72;
  u16* sQ = (u16*)smem;
  u16* sK = sQ + 64 * LD;
  u16* sKbT = sK + 64 * LD;
  u16* sVbT = sKbT + 128 * LT;
  u16* sKtT = sVbT + 128 * LT;
  u16* sT = sKtT + 128 * LT;
  u16* sQK = sT + 64 * LT;
  float* sL = (float*)(sQK + 64 * LT);
  float* sG = sL + 64 * 68;
  float* sBe = sG + 64;
  float* sEk = sBe + 64;
  float* sEg = sEk + 64;
  float* sCW = sEg + 64;
  u16* sTT = (u16*)(sCW + 4 * 384);
  u16* sWT = sKbT;
  u16* sUT = sVbT;
  int tid = threadIdx.x;
  asm volatile("" : "+v"(tid));
  char* ws = p.ws;
  float* outp = p.out;
  asm volatile("" : "+s"(ws), "+s"(outp));
  const int lane = tid & 63, wid = tid >> 6, r = lane & 31, h = lane >> 5;
  const ChunkInfo ci = chunk_info(c);
  const int ch = c * 4 + hd;
  const u16* PGDN = (const u16*)(ws + OFF_PGDN);
  const float* PSM = outp + OOFF_PSMALL;
  if (wid == 0) {
    const int n = lane;
    float la = 0.f, be = 0.f;
    if (n < ci.valid) {
      const int tok = ci.tok0 + n;
      const float da = PSM[(size_t)tok * 32 + 16 + hd], db = PSM[(size_t)tok * 32 + 20 + hd];
      be = sigmoidf_(db);
      la = -__expf(p.gdn_a_log[hd]) * softplusf_(da + p.gdn_dt_bias[hd]);
    }
    float G = la;
#pragma unroll
    for (int off = 1; off < 64; off <<= 1) { const float t = __shfl_up(G, off); if (lane >= off) G += t; }
    const float glast = __shfl(G, 63);
    sG[n] = G; sBe[n] = be; sEk[n] = __expf(glast - G); sEg[n] = __expf(G);
    if (lane == 0) ((float*)(ws + OFF_GDEC))[ch] = __expf(glast);
  }
  for (int e = tid; e < 4 * 384; e += NTHR) {
    const int tap = e / 384, cc = e % 384;
    sCW[e] = p.gdn_conv_w[tap * 1536 + (cc >> 7) * 512 + hd * 128 + (cc & 127)];
  }
  {
    const int n = tid >> 3, g = tid & 7;
    uint4 raw[3][4][2];
#pragma unroll
    for (int part = 0; part < 3; ++part)
#pragma unroll
      for (int i = 0; i < 4; ++i) {
        const int pos = n - 3 + i;
        const int col0 = part * 512 + hd * 128 + g * 16;
        uint4 a = make_uint4(0, 0, 0, 0), b = a;
        if (n < ci.valid) {
          if (pos >= 0 || (!ci.sample && ci.cl > 0)) {
            const uint4* sp = (const uint4*)(PGDN + (size_t)(ci.tok0 + pos) * 1536 + col0);
            a = sp[0]; b = sp[1];
          } else if (ci.sample) {
            const float* cb = p.state_conv + ((size_t)ci.seq * 3 + (3 + pos)) * 1536 + col0;
            a.x = pk2(cb[0], cb[1]); a.y = pk2(cb[2], cb[3]); a.z = pk2(cb[4], cb[5]); a.w = pk2(cb[6], cb[7]);
            b.x = pk2(cb[8], cb[9]); b.y = pk2(cb[10], cb[11]); b.z = pk2(cb[12], cb[13]); b.w = pk2(cb[14], cb[15]);
          }
        }
        raw[part][i][0] = a; raw[part][i][1] = b;
      }
    __syncthreads();
#pragma unroll
    for (int part = 0; part < 3; ++part) {
      float v[16];
#pragma unroll
      for (int j = 0; j < 16; ++j) v[j] = 0.f;
#pragma unroll
      for (int i = 0; i < 4; ++i) {
        float sv[16];
        unpack16(raw[part][i][0], raw[part][i][1], sv);
        const float4* cw = (const float4*)(sCW + i * 384 + part * 128 + g * 16);
#pragma unroll
        for (int q4 = 0; q4 < 4; ++q4) {
          const float4 w4 = cw[q4];
          v[4 * q4] += sv[4 * q4] * w4.x; v[4 * q4 + 1] += sv[4 * q4 + 1] * w4.y; v[4 * q4 + 2] += sv[4 * q4 + 2] * w4.z; v[4 * q4 + 3] += sv[4 * q4 + 3] * w4.w;
        }
      }
#pragma unroll
      for (int j = 0; j < 16; ++j) v[j] = v[j] * __builtin_amdgcn_rcpf(1.f + __expf(-v[j]));
      if (part < 2) {
        float ss = 0.f;
#pragma unroll
        for (int j = 0; j < 16; ++j) ss += v[j] * v[j];
        ss += __shfl_xor(ss, 1); ss += __shfl_xor(ss, 2); ss += __shfl_xor(ss, 4);
        const float sc = rsqrtf(ss + 1e-6f) * (part == 0 ? 0.08838834764831845f : 1.f);
#pragma unroll
        for (int j = 0; j < 16; ++j) v[j] *= sc;
        u16* dst = (part == 0 ? sQ : sK) + n * LD + g * 16;
        uint4 o0, o1;
        o0.x = pk2(v[0], v[1]); o0.y = pk2(v[2], v[3]); o0.z = pk2(v[4], v[5]); o0.w = pk2(v[6], v[7]);
        o1.x = pk2(v[8], v[9]); o1.y = pk2(v[10], v[11]); o1.z = pk2(v[12], v[13]); o1.w = pk2(v[14], v[15]);
        *(uint4*)dst = o0; *(uint4*)(dst + 8) = o1;
      }
      if (part == 1) {
        const float sb = sBe[n] * sEg[n], sk = sEk[n];
#pragma unroll
        for (int j = 0; j < 16; ++j) {
          const float kr = bf2f(f2bf(v[j]));
          sKbT[(g * 16 + j) * LT + n] = f2bf(kr * sb);
          sKtT[(g * 16 + j) * LT + n] = f2bf(kr * sk);
        }
      } else if (part == 2) {
        const float sb = sBe[n];
#pragma unroll
        for (int j = 0; j < 16; ++j) sVbT[(g * 16 + j) * LT + n] = f2bf(bf2f(f2bf(v[j])) * sb);
      }
    }
  }
  __syncthreads();
  {
    const int which = wid >> 2, ti = (wid >> 1) & 1, tj = wid & 1;
    f32x16 acc;
#pragma unroll
    for (int i = 0; i < 16; ++i) acc[i] = 0.f;
    mma_tile_vec<8>(acc, (which ? sQ : sK) + 32 * ti * LD, LD, sK + 32 * tj * LD, LD, r, h);
#pragma unroll
    for (int i = 0; i < 16; ++i) {
      const int n = 32 * ti + crow(i, h), m = 32 * tj + r;
      const float d = __expf(fminf(sG[n] - sG[m], 0.f));
      if (which == 0) sL[n * 68 + m] = (m < n) ? sBe[n] * acc[i] * d : 0.f;
      else sQK[n * LT + m] = (m <= n) ? f2bf(acc[i] * d) : (u16)0;
    }
  }
  __syncthreads();
  if (wid == 0) {
    const int hb = lane >> 5, cl = lane & 31;
    float x[32];
#pragma unroll
    for (int i = 0; i < 32; ++i) x[i] = 0.f;
    const float* sLr = sL + (32 * hb) * 68 + 32 * hb;
    asm volatile("" : "+v"(sLr));
#pragma unroll
    for (int i = 0; i < 32; ++i) {
      float a0 = fmaxf(1.f - fabsf((float)(cl - i)), 0.f), a1 = 0.f, a2 = 0.f, a3 = 0.f;
#pragma unroll
      for (int jj = 0; jj * 4 < i; ++jj) {
        const float4 l = *(const float4*)(sLr + i * 68 + jj * 4);
        a0 -= l.x * x[4 * jj]; a1 -= l.y * x[4 * jj + 1]; a2 -= l.z * x[4 * jj + 2]; a3 -= l.w * x[4 * jj + 3];
      }
      const float a = (a0 + a1) + (a2 + a3);
      x[i] = a;
      sT[(32 * hb + i) * LT + 32 * hb + cl] = f2bf(a);
      if (hb == 0) { sT[i * LT + 32 + cl] = 0; sTT[cl * LT + i] = f2bf(a); }
    }
    f32x16 P;
#pragma unroll
    for (int i = 0; i < 16; ++i) P[i] = 0.f;
#pragma unroll
    for (int s2 = 0; s2 < 2; ++s2) {
      const float4 l0 = *(const float4*)(sL + (32 + r) * 68 + 16 * s2 + 8 * h), l1 = *(const float4*)(sL + (32 + r) * 68 + 16 * s2 + 8 * h + 4);
      u32x4 aw; aw.x = pk2(l0.x, l0.y); aw.y = pk2(l0.z, l0.w); aw.z = pk2(l1.x, l1.y); aw.w = pk2(l1.z, l1.w);
      const bf16x8 a = __builtin_bit_cast(bf16x8, aw);
      const bf16x8 b = *(const bf16x8*)(sTT + r * LT + 16 * s2 + 8 * h);
      P = MFMA(a, b, P);
    }
    f32x16 Q;
#pragma unroll
    for (int i = 0; i < 16; ++i) Q[i] = 0.f;
#pragma unroll
    for (int s2 = 0; s2 < 2; ++s2) {
      const uint2 t0 = *(const uint2*)(sT + (32 + r) * LT + 32 + 16 * s2 + 4 * h), t1 = *(const uint2*)(sT + (32 + r) * LT + 32 + 16 * s2 + 8 + 4 * h);
      u32x4 aw; aw.x = t0.x; aw.y = t0.y; aw.z = t1.x; aw.w = t1.y;
      Q = MFMA(__builtin_bit_cast(bf16x8, aw), pack8(P, s2), Q);
    }
#pragma unroll
    for (int i = 0; i < 16; ++i) sT[(32 + crow(i, h)) * LT + r] = f2bf(-Q[i]);
  } else {
    const int r0 = ch * 16 + (wid - 1);
    float4 tv[3][4];
#pragma unroll
    for (int k = 0; k < 3; ++k) {
      const int row = r0 + 7 * k;
      if (row < ch * 16 + 16 && row < 32768) {
        const float* src = (row < 16384 ? p.peer_u + (size_t)row * 1024 : p.peer_v + (size_t)(row - 16384) * 1024) + lane * 16;
#pragma unroll
        for (int q = 0; q < 4; ++q) tv[k][q] = ((const float4*)src)[q];
      }
    }
#pragma unroll
    for (int k = 0; k < 3; ++k) {
      const int row = r0 + 7 * k;
      if (row < ch * 16 + 16 && row < 32768) {
        float am = 0.f;
#pragma unroll
        for (int q = 0; q < 4; ++q) am = fmaxf(am, fmaxf(fmaxf(fabsf(tv[k][q].x), fabsf(tv[k][q].y)), fmaxf(fabsf(tv[k][q].z), fabsf(tv[k][q].w))));
#pragma unroll
        for (int o = 32; o > 0; o >>= 1) am = fmaxf(am, __shfl_xor(am, o));
        const float sc = am > 0.f ? 256.f / am : 1.f;
        unsigned w4[4];
#pragma unroll
        for (int q = 0; q < 4; ++q) {
          int t = 0;
          t = __builtin_amdgcn_cvt_pk_fp8_f32(tv[k][q].x * sc, tv[k][q].y * sc, t, false);
          t = __builtin_amdgcn_cvt_pk_fp8_f32(tv[k][q].z * sc, tv[k][q].w * sc, t, true);
          w4[q] = (unsigned)t;
        }
        unsigned char* dstb = (unsigned char*)(ws + (row < 16384 ? OFF_UB : OFF_VB)) + (size_t)(row & 16383) * 1024 + lane * 16;
        *(uint4*)dstb = make_uint4(w4[0], w4[1], w4[2], w4[3]);
        if (lane == 0) ((float*)(ws + (row < 16384 ? OFF_USC : OFF_VSC)))[row & 16383] = am > 0.f ? am * (1.f / 256.f) : 1.f;
      }
    }
  }
  __syncthreads();
  {
    f32x16 acc2[2];
#pragma unroll
    for (int z = 0; z < 2; ++z) {
      const int q = wid * 2 + z, which = q >> 3, ti = (q >> 2) & 1, tj = q & 3;
#pragma unroll
      for (int i = 0; i < 16; ++i) acc2[z][i] = 0.f;
      mma_tile_vec<4>(acc2[z], sT + 32 * ti * LT, LT, (which ? sVbT : sKbT) + 32 * tj * LT, LT, r, h);
    }
    __syncthreads();
#pragma unroll
    for (int z = 0; z < 2; ++z) {
      const int q = wid * 2 + z, which = q >> 3, ti = (q >> 2) & 1, tj = q & 3;
      const float sg = which ? 1.f : -1.f;
      u16* dst = (which ? sUT : sWT) + (32 * tj + r) * LT + 32 * ti + 4 * h;
#pragma unroll
      for (int g = 0; g < 4; ++g) {
        uint2 o;
        o.x = pk2(sg * acc2[z][4 * g], sg * acc2[z][4 * g + 1]);
        o.y = pk2(sg * acc2[z][4 * g + 2], sg * acc2[z][4 * g + 3]);
        *(uint2*)(dst + 8 * g) = o;
      }
    }
  }
  __syncthreads();
  char* gi = ws + OFF_GI + (size_t)ch * 98304;
#pragma unroll 1
  for (int q = wid; q < 48; q += 8) {
    f32x16 acc;
#pragma unroll
    for (int i = 0; i < 16; ++i) acc[i] = 0.f;
    if (q < 16) {
      const int t_in = q >> 2, t_out = q & 3;
      mma_tile_vec<4>(acc, sWT + 32 * t_in * LT, LT, sKtT + 32 * t_out * LT, LT, r, h);
#pragma unroll
      for (int s2 = 0; s2 < 2; ++s2) *(bf16x8*)(gi + ((size_t)((t_out * 8 + 2 * t_in + s2) * 64 + lane)) * 16) = pack8(acc, s2);
    } else if (q < 32) {
      const int t = (q - 16) >> 2, we = (q - 16) & 3;
      mma_tile_vec<4>(acc, sKtT + 32 * t * LT, LT, sUT + 32 * we * LT, LT, r, h);
      char* dst = gi + 32768 + ((size_t)((we * 4 + t) * 64 + lane)) * 32;
      *(bf16x8*)dst = pack8(acc, 0); *(bf16x8*)(dst + 16) = pack8(acc, 1);
    } else if (q < 40) {
      const int td = (q - 32) >> 1, tn = (q - 32) & 1;
      const float eg = sEg[32 * tn + r];
#pragma unroll
      for (int g = 0; g < 4; ++g) {
        const uint2 qv = *(const uint2*)(sQ + (32 * tn + r) * LD + 32 * td + 8 * g + 4 * h);
        acc[4 * g] = bflo(qv.x) * eg; acc[4 * g + 1] = bfhi(qv.x) * eg; acc[4 * g + 2] = bflo(qv.y) * eg; acc[4 * g + 3] = bfhi(qv.y) * eg;
      }
      mma_tile_vec<4>(acc, sWT + 32 * td * LT, LT, sQK + 32 * tn * LT, LT, r, h);
#pragma unroll
      for (int s2 = 0; s2 < 2; ++s2) *(bf16x8*)(gi + 65536 + ((size_t)((tn * 8 + 2 * td + s2) * 64 + lane)) * 16) = pack8(acc, s2);
    } else {
      const int tn = (q - 40) >> 2, we = (q - 40) & 3;
      mma_tile_vec<4>(acc, sQK + 32 * tn * LT, LT, sUT + 32 * we * LT, LT, r, h);
      char* dst = gi + 81920 + ((size_t)((we * 2 + tn) * 64 + lane)) * 32;
      *(bf16x8*)dst = pack8(acc, 0); *(bf16x8*)(dst + 16) = pack8(acc, 1);
    }
  }
  __syncthreads();
}

struct GlaLds { u16 *sQ, *sK, *sV; float *sG, *sX; };
DI GlaLds gla_carve(char* smem) {
  GlaLds L;
  L.sQ = (u16*)smem; L.sK = L.sQ + 64 * 72; L.sV = L.sK + 64 * 72;
  L.sG = (float*)(L.sV + 64 * 136); L.sX = L.sG + 64 * 65;
  return L;
}
DI void gla_load(const Params& p, int c, int hd, const GlaLds& L) {
  int tid = threadIdx.x;
  asm volatile("" : "+v"(tid));
  char* ws = p.ws;
  float* outp = p.out;
  asm volatile("" : "+s"(ws), "+s"(outp));
  const ChunkInfo ci = chunk_info(c);
  const u16* PG = (const u16*)(ws + OFF_PGLA);
  const float* PSM = outp + OOFF_PSMALL;
  {
    const int n = tid >> 3, g = tid & 7;
    uint4 q4 = make_uint4(0, 0, 0, 0), k4 = q4, v0 = q4, v1 = q4;
    if (n < ci.valid) {
      const u16* rowp = PG + (size_t)(ci.tok0 + n) * 1024;
      q4 = *(const uint4*)(rowp + hd * 64 + g * 8);
      k4 = *(const uint4*)(rowp + 256 + hd * 64 + g * 8);
      v0 = *(const uint4*)(rowp + 512 + hd * 128 + g * 16);
      v1 = *(const uint4*)(rowp + 512 + hd * 128 + g * 16 + 8);
      q4.x = pk2(bflo(q4.x) * 0.125f, bfhi(q4.x) * 0.125f); q4.y = pk2(bflo(q4.y) * 0.125f, bfhi(q4.y) * 0.125f);
      q4.z = pk2(bflo(q4.z) * 0.125f, bfhi(q4.z) * 0.125f); q4.w = pk2(bflo(q4.w) * 0.125f, bfhi(q4.w) * 0.125f);
    }
    *(uint4*)(L.sQ + n * 72 + g * 8) = q4;
    *(uint4*)(L.sK + n * 72 + g * 8) = k4;
    *(uint4*)(L.sV + n * 136 + g * 16) = v0;
    *(uint4*)(L.sV + n * 136 + g * 16 + 8) = v1;
  }
  for (int e = tid; e < 64 * 16; e += NTHR) {
    const int n = e >> 4, rr = e & 15;
    L.sX[e] = (n < ci.valid) ? PSM[(size_t)(ci.tok0 + n) * 32 + rr] : 0.f;
  }
  __syncthreads();
  {
    const int d = tid & 63, n0 = (tid >> 6) * 8;
    float wk[16];
#pragma unroll
    for (int rr = 0; rr < 16; ++rr) wk[rr] = p.gla_w_gk2[rr * 256 + hd * 64 + d];
    const float bias = p.gla_b_gk[hd * 64 + d];
    float run = 0.f, la[8];
#pragma unroll
    for (int i = 0; i < 8; ++i) {
      const int n = n0 + i;
      float z = bias;
#pragma unroll
      for (int rr = 0; rr < 16; ++rr) z += L.sX[n * 16 + rr] * wk[rr];
      float ls = fminf(z, 0.f) - __logf(1.f + __expf(-fabsf(z)));
      ls = (n < ci.valid) ? ls * (1.f / 16.f) : 0.f;
      run += ls; la[i] = run;
    }
    float* part = L.sX + 1024;
    part[(tid >> 6) * 64 + d] = run;
    __syncthreads();
    float pre = 0.f;
    for (int b = 0; b < (tid >> 6); ++b) pre += part[b * 64 + d];
#pragma unroll
    for (int i = 0; i < 8; ++i) L.sG[(n0 + i) * 65 + d] = la[i] + pre;
  }
  __syncthreads();
}

DI void gla_prep(const Params& p, int c, int hd, char* smem) {
  const GlaLds L = gla_carve(smem);
  int tid = threadIdx.x;
  asm volatile("" : "+v"(tid));
  char* ws = p.ws;
  float* outp = p.out;
  asm volatile("" : "+s"(ws), "+s"(outp));
  const int lane = tid & 63, wid = tid >> 6, r = lane & 31, h = lane >> 5;
  const int ch = c * 4 + hd;
  gla_load(p, c, hd, L);
  const int td = wid >> 2, te = wid & 3;
  f32x16 acc;
#pragma unroll
  for (int i = 0; i < 16; ++i) acc[i] = 0.f;
  mma_tile<4>(acc, [&](int i, int k) { const int d = 32 * td + i; return f2bf(bf2f(L.sK[k * 72 + d]) * __expf(L.sG[63 * 65 + d] - L.sG[k * 65 + d])); },
              [&](int k, int j) { return L.sV[k * 136 + 32 * te + j]; }, r, h);
  float* GB = outp + OOFF_GB + (size_t)ch * 8192;
#pragma unroll
  for (int i = 0; i < 16; ++i) GB[(32 * td + crow(i, h)) * 128 + 32 * te + r] = acc[i];
  if (tid < 64) (outp + OOFF_GLD)[(size_t)ch * 64 + tid] = __expf(L.sG[63 * 65 + tid]);
  __syncthreads();
}

DI void gla_out(const Params& p, int c, int hd, char* smem) {
  const GlaLds L = gla_carve(smem);
  u16* sS = (u16*)(L.sX + 1024 + 512);
  u16* sAtt = sS + 64 * 136;
  float* sO = (float*)(sAtt + 64 * 72);
  int tid = threadIdx.x;
  asm volatile("" : "+v"(tid));
  char* ws = p.ws;
  float* outp = p.out;
  asm volatile("" : "+s"(ws), "+s"(outp));
  const int lane = tid & 63, wid = tid >> 6, r = lane & 31, h = lane >> 5;
  const int ch = c * 4 + hd;
  const ChunkInfo ci = chunk_info(c);
  gla_load(p, c, hd, L);
  {
    const float* GB = outp + OOFF_GB + (size_t)ch * 8192;
    for (int e = tid; e < 64 * 32; e += NTHR) {
      const int d = e >> 5, q4 = e & 31;
      const float4 v = ((const float4*)GB)[e];
      uint2 o; o.x = pk2(v.x, v.y); o.y = pk2(v.z, v.w);
      *(uint2*)(sS + d * 136 + q4 * 4) = o;
    }
  }
  if (wid < 4) {
    const int ti = wid >> 1, tj = wid & 1;
    if (!(ti == 0 && tj == 1)) {
      f32x16 acc;
#pragma unroll
      for (int i = 0; i < 16; ++i) acc[i] = 0.f;
      mma_tile<4>(acc, [&](int i, int k) { const int n = 32 * ti + i; return f2bf(bf2f(L.sQ[n * 72 + k]) * __expf(L.sG[n * 65 + k] - L.sG[32 * 65 + k])); },
                  [&](int k, int j) { const int m = 32 * tj + j; return f2bf(bf2f(L.sK[m * 72 + k]) * __expf(L.sG[32 * 65 + k] - L.sG[m * 65 + k])); }, r, h);
#pragma unroll
      for (int i = 0; i < 16; ++i) { const int n = 32 * ti + crow(i, h), m = 32 * tj + r; sAtt[n * 72 + m] = (m <= n) ? f2bf(acc[i]) : (u16)0; }
    } else {
#pragma unroll
      for (int i = 0; i < 16; ++i) sAtt[(crow(i, h)) * 72 + 32 + r] = 0;
    }
  }
  __syncthreads();
  {
    const int tn = wid >> 2, te = wid & 3;
    f32x16 acc;
#pragma unroll
    for (int i = 0; i < 16; ++i) acc[i] = 0.f;
    mma_tile<4>(acc, [&](int i, int k) { const int n = 32 * tn + i; return f2bf(bf2f(L.sQ[n * 72 + k]) * __expf(L.sG[n * 65 + k])); },
                [&](int k, int j) { return sS[k * 136 + 32 * te + j]; }, r, h);
    mma_tile<4>(acc, [&](int i, int k) { return sAtt[(32 * tn + i) * 72 + k]; },
                [&](int k, int j) { return L.sV[k * 136 + 32 * te + j]; }, r, h);
#pragma unroll
    for (int i = 0; i < 16; ++i) sO[(32 * tn + crow(i, h)) * 132 + 32 * te + r] = acc[i];
  }
  __syncthreads();
  {
    const int n = tid >> 3, g = tid & 7;
    float v[16], ss = 0.f;
#pragma unroll
    for (int j = 0; j < 16; ++j) { v[j] = sO[n * 132 + g * 16 + j]; ss += v[j] * v[j]; }
    ss += __shfl_xor(ss, 1); ss += __shfl_xor(ss, 2); ss += __shfl_xor(ss, 4);
    const float rs = rsqrtf(ss * (1.f / 128.f) + 1e-6f);
    if (n < ci.valid) {
      const int tok = ci.tok0 + n;
      const u16* gp = (const u16*)(ws + OFF_PGATE) + (size_t)tok * 1024 + hd * 128 + g * 16;
      const uint4 g0 = *(const uint4*)gp, g1 = *(const uint4*)(gp + 8);
      const unsigned gg[8] = {g0.x, g0.y, g0.z, g0.w, g1.x, g1.y, g1.z, g1.w};
      unsigned o[8];
#pragma unroll
      for (int j = 0; j < 8; ++j) {
        const float ga = bflo(gg[j]), gb = bfhi(gg[j]);
        const float a = v[2 * j] * rs * p.gla_norm_w[g * 16 + 2 * j] * (ga * __builtin_amdgcn_rcpf(1.f + __expf(-ga)));
        const float b = v[2 * j + 1] * rs * p.gla_norm_w[g * 16 + 2 * j + 1] * (gb * __builtin_amdgcn_rcpf(1.f + __expf(-gb)));
        o[j] = pk2(a, b);
      }
      u16* op = (u16*)(ws + OFF_O) + (size_t)tok * 1024 + hd * 128 + g * 16;
      *(uint4*)op = make_uint4(o[0], o[1], o[2], o[3]);
      *(uint4*)(op + 8) = make_uint4(o[4], o[5], o[6], o[7]);
    }
  }
  __syncthreads();
}

constexpr int PF = 3;
constexpr int GLA_OUT_EARLY = 1152;
template <int NCHUNKS, int ROLE>
DI void chain_loop(const Params& p, int c0, int sb, int hd, int t, int w, int lane, bf16x8* spbuf) {
  const int r = lane & 31, hh = lane >> 5;
  const bool sample = NCHUNKS == 1;
  const size_t offA = (ROLE == 0 ? (size_t)t * 8192 : 65536 + (size_t)t * 8192) + (size_t)lane * 16;
  const size_t offB = (ROLE == 0 ? 32768 + (size_t)(w * 4 + t) * 2048 : 81920 + (size_t)(w * 2 + t) * 2048) + (size_t)lane * 32;
  f32x16 S;
#pragma unroll
  for (int i = 0; i < 16; ++i)
    S[i] = (sample && ROLE == 0) ? p.state_gdn[((size_t)(sb * 4 + hd) * 128 + 32 * t + crow(i, hh)) * 128 + 32 * w + r] : 0.f;
  const float* GDEC = (const float*)(p.ws + OFF_GDEC);
  u16* O2 = (u16*)(p.ws + OFF_R1);
  bf16x8 ra[PF][8];
  uint4 rb[PF][2];
  float rdec[PF];
#define CH_LOAD(slot, cc)                                                                              \
  if (ROLE != 2) {                                                                                     \
    const int cq_ = (cc) < NCHUNKS ? (cc) : NCHUNKS - 1;                                               \
    const int ch_ = (c0 + cq_) * 4 + hd;                                                               \
    const char* gi_ = p.ws + OFF_GI + (size_t)ch_ * 98304;                                             \
    _Pragma("unroll") for (int ks = 0; ks < 8; ++ks) ra[slot][ks] = *(const bf16x8*)(gi_ + offA + ks * 1024); \
    rb[slot][0] = *(const uint4*)(gi_ + offB); rb[slot][1] = *(const uint4*)(gi_ + offB + 16);        \
    rdec[slot] = GDEC[ch_];                                                                            \
  }
#define CH_STEP(u, c)                                                                                  \
  {                                                                                                    \
    CH_LOAD((u + PF - 1) % PF, (c) + PF - 1);                                                          \
    bf16x8* sp = spbuf + ((c) & 1) * 512;                                                              \
    if (ROLE == 0) { sp[(2 * t) * 64 + lane] = pack8(S, 0); sp[(2 * t + 1) * 64 + lane] = pack8(S, 1); } \
    LDS_BARRIER();                                                                                     \
    if (ROLE != 2) {                                                                                   \
      const unsigned bb[8] = {rb[u][0].x, rb[u][0].y, rb[u][0].z, rb[u][0].w, rb[u][1].x, rb[u][1].y, rb[u][1].z, rb[u][1].w}; \
      const float dec = rdec[u];                                                                       \
      f32x16 acc0;                                                                                     \
      _Pragma("unroll") for (int j = 0; j < 8; ++j) { acc0[2 * j] = S[2 * j] * dec + bflo(bb[j]); acc0[2 * j + 1] = S[2 * j + 1] * dec + bfhi(bb[j]); } \
      _Pragma("unroll") for (int ks = 0; ks < 8; ++ks) acc0 = MFMA(ra[u][ks], sp[ks * 64 + lane], acc0); \
      if (ROLE == 0) {                                                                                 \
        S = acc0;                                                                                      \
      } else {                                                                                         \
        const int tok0_ = sample ? T_P + sb * 32 : (c0 + (c)) * 64;                                    \
        _Pragma("unroll") for (int i = 0; i < 16; ++i) {                                               \
          const int n = 32 * t + crow(i, hh);                                                          \
          if (!sample || n < 32) O2[(size_t)(tok0_ + n) * 512 + hd * 128 + 32 * w + r] = f2bf(acc0[i]); \
        }                                                                                              \
      }                                                                                                \
    }                                                                                                  \
  }
#pragma unroll
  for (int u = 0; u < PF - 1; ++u) { CH_LOAD(u, u); }
  constexpr int NMAIN = (NCHUNKS / PF) * PF;
#pragma unroll 1
  for (int cb = 0; cb < NMAIN; cb += PF) {
    CH_STEP(0, cb);
    CH_STEP(1, cb + 1);
    CH_STEP(2, cb + 2);
  }
  if (NCHUNKS - NMAIN >= 1) CH_STEP(0, NMAIN);
  if (NCHUNKS - NMAIN >= 2) CH_STEP(1, NMAIN + 1);
#undef CH_STEP
#undef CH_LOAD
  if (ROLE == 0) {
    float* dst = p.out + (sample ? OUT_GDN_S : OUT_GDN_P) + (size_t)(sb * 4 + hd) * 16384;
#pragma unroll
    for (int i = 0; i < 16; ++i) dst[(32 * t + crow(i, hh)) * 128 + 32 * w + r] = S[i];
  }
}

template <int NCHUNKS>
DI void gdn_chain2(const Params& p, int chain, int w, char* smem) {
  int tid = threadIdx.x;
  asm volatile("" : "+v"(tid));
  const int lane = tid & 63, wid = __builtin_amdgcn_readfirstlane(tid >> 6);
  bf16x8* spbuf = (bf16x8*)smem;
  int sb, hd, c0;
  if (NCHUNKS != 1) { sb = chain >> 2; hd = chain & 3; c0 = sb * 128; }
  else { sb = (chain - 16) >> 2; hd = (chain - 16) & 3; c0 = 512 + sb; }
  if (wid < 4) chain_loop<NCHUNKS, 0>(p, c0, sb, hd, wid, w, lane, spbuf);
  else if (wid < 6) chain_loop<NCHUNKS, 1>(p, c0, sb, hd, wid - 4, w, lane, spbuf);
  else chain_loop<NCHUNKS, 2>(p, c0, sb, hd, 0, w, lane, spbuf);
  __syncthreads();
}

DI void phase3(const Params& p, char* smem) {
  const int tid = threadIdx.x;
  const int b = blockIdx.x;
  if (b < 64) {
    const int x = b & 7, j = b >> 3;
    gdn_chain2<128>(p, x * 2 + (j >> 2), j & 3, smem);
#ifdef REP_P3
    gdn_chain2<128>(p, x * 2 + (j >> 2), j & 3, smem);
#endif
    return;
  }
  const int nb = gridDim.x - 64;
  for (int u = b - 64; u < 256; u += nb) gdn_chain2<1>(p, 16 + (u >> 2), u & 3, smem);
  const int gt = (b - 64) * NTHR + tid, gn = nb * NTHR;
  float* GB = p.out + OOFF_GB;
  const float* GLD = p.out + OOFF_GLD;
  for (int e = gt; e < 16 * 2048; e += gn) {
    const int sh = e >> 11, de4 = e & 2047, d = de4 >> 5;
    const int seq = sh >> 2, hd = sh & 3;
    float4 S = make_float4(0.f, 0.f, 0.f, 0.f);
    for (int cl = 0; cl < 128; cl += 8) {
      float4 bn[8];
      float dc[8];
#pragma unroll
      for (int u = 0; u < 8; ++u) {
        const int ch = (seq * 128 + cl + u) * 4 + hd;
        bn[u] = ((const float4*)(GB + (size_t)ch * 8192))[de4];
        dc[u] = GLD[(size_t)ch * 64 + d];
      }
#pragma unroll
      for (int u = 0; u < 8; ++u) {
        const int ch = (seq * 128 + cl + u) * 4 + hd;
        ((float4*)(GB + (size_t)ch * 8192))[de4] = S;
        S.x = dc[u] * S.x + bn[u].x; S.y = dc[u] * S.y + bn[u].y; S.z = dc[u] * S.z + bn[u].z; S.w = dc[u] * S.w + bn[u].w;
      }
    }
    ((float4*)(p.out + OUT_GLA_P + (size_t)sh * 8192))[de4] = S;
  }
  for (int e = gt; e < 64 * 2048; e += gn) {
    const int sh = e >> 11, de4 = e & 2047, d = de4 >> 5;
    const int sb = sh >> 2, hd = sh & 3;
    const int ch = (512 + sb) * 4 + hd;
    const float4 S0 = ((const float4*)(p.state_gla + (size_t)sh * 8192))[de4];
    const float4 bnew = ((const float4*)(GB + (size_t)ch * 8192))[de4];
    const float dec = GLD[(size_t)ch * 64 + d];
    ((float4*)(GB + (size_t)ch * 8192))[de4] = S0;
    ((float4*)(p.out + OUT_GLA_S + (size_t)sh * 8192))[de4] = make_float4(dec * S0.x + bnew.x, dec * S0.y + bnew.y, dec * S0.z + bnew.z, dec * S0.w + bnew.w);
  }
  {
    unsigned* ctr = (unsigned*)(p.ws + OFF_BAR);
    asm volatile("s_waitcnt vmcnt(0)" ::: "memory");
    __syncthreads();
    if (tid == 0) {
      __builtin_amdgcn_fence(__ATOMIC_RELEASE, "agent");
      asm volatile("s_waitcnt vmcnt(0)" ::: "memory");
      __hip_atomic_fetch_add(ctr, 1u, __ATOMIC_RELAXED, __HIP_MEMORY_SCOPE_AGENT);
      unsigned sp = 0;
      while (__hip_atomic_load(ctr, __ATOMIC_RELAXED, __HIP_MEMORY_SCOPE_AGENT) < (unsigned)nb) { __builtin_amdgcn_s_sleep(2); if (++sp > (1u << 22)) break; }
      __builtin_amdgcn_fence(__ATOMIC_ACQUIRE, "agent");
      asm volatile("s_waitcnt vmcnt(0)" ::: "memory");
    }
    __syncthreads();
  }
  for (int u = b - 64; u < GLA_OUT_EARLY; u += nb) gla_out(p, u >> 2, u & 3, smem);
}

DI void phase4_misc(const Params& p) {
  const int tid = threadIdx.x, lane = tid & 63;
  for (int i = blockIdx.x * NTHR + tid; i < T_ALL; i += gridDim.x * NTHR) ((float*)(p.ws + OFF_RSS))[i] = 0.f;
  const int gw = blockIdx.x * (NTHR / 64) + (tid >> 6), nw = gridDim.x * (NTHR / 64);
  const u16* O2 = (const u16*)(p.ws + OFF_R1);
  const u16* PGATE = (const u16*)(p.ws + OFF_PGATE);
  u16* O = (u16*)(p.ws + OFF_O);
  for (int tok = gw; tok < T_ALL; tok += nw) {
    const uint4 ov = *(const uint4*)(O2 + (size_t)tok * 512 + lane * 8);
    const uint4 zv = *(const uint4*)(PGATE + (size_t)tok * 1024 + 512 + lane * 8);
    const unsigned oo[4] = {ov.x, ov.y, ov.z, ov.w}, zz[4] = {zv.x, zv.y, zv.z, zv.w};
    float v[8], ss = 0.f;
#pragma unroll
    for (int j = 0; j < 4; ++j) { v[2 * j] = bflo(oo[j]); v[2 * j + 1] = bfhi(oo[j]); ss += v[2 * j] * v[2 * j] + v[2 * j + 1] * v[2 * j + 1]; }
    ss += __shfl_xor(ss, 1); ss += __shfl_xor(ss, 2); ss += __shfl_xor(ss, 4); ss += __shfl_xor(ss, 8);
    const float rs = rsqrtf(ss * (1.f / 128.f) + 1e-6f);
    unsigned o[4];
#pragma unroll
    for (int j = 0; j < 4; ++j) {
      const float za = bflo(zz[j]), zb = bfhi(zz[j]);
      const int e = (lane & 15) * 8 + 2 * j;
      const float a = v[2 * j] * rs * p.gdn_norm_w[e] * (za * __builtin_amdgcn_rcpf(1.f + __expf(-za)));
      const float b = v[2 * j + 1] * rs * p.gdn_norm_w[e + 1] * (zb * __builtin_amdgcn_rcpf(1.f + __expf(-zb)));
      o[j] = pk2(a, b);
    }
    *(uint4*)(O + (size_t)tok * 1024 + 512 + lane * 8) = make_uint4(o[0], o[1], o[2], o[3]);
  }
}

DI void conv_state_out(const Params& p) {
  const int gtid = blockIdx.x * NTHR + threadIdx.x, gn = gridDim.x * NTHR;
  const u16* PGDN = (const u16*)(p.ws + OFF_PGDN);
  for (int e = gtid; e < 4 * 3 * 1536; e += gn) {
    const int col = e % 1536, j = (e / 1536) % 3, b = e / (3 * 1536);
    p.out[OUT_CONV_P + e] = bf2f(PGDN[(size_t)(b * 8192 + 8189 + j) * 1536 + col]);
  }
  for (int e = gtid; e < 16 * 3 * 1536; e += gn) {
    const int col = e % 1536, j = (e / 1536) % 3, b = e / (3 * 1536);
    p.out[OUT_CONV_S + e] = bf2f(PGDN[(size_t)(T_P + b * 32 + 29 + j) * 1536 + col]);
  }
}

DI unsigned dpp_max_row(unsigned v) {
  v = max(v, (unsigned)__builtin_amdgcn_update_dpp(0, (int)v, 0xB1, 0xF, 0xF, false));
  v = max(v, (unsigned)__builtin_amdgcn_update_dpp(0, (int)v, 0x4E, 0xF, 0xF, false));
  v = max(v, (unsigned)__builtin_amdgcn_update_dpp(0, (int)v, 0x141, 0xF, 0xF, false));
  v = max(v, (unsigned)__builtin_amdgcn_update_dpp(0, (int)v, 0x140, 0xF, 0xF, false));
  return v;
}
DI float dpp_sum_row(float v) {
  v += __builtin_bit_cast(float, __builtin_amdgcn_update_dpp(0, __builtin_bit_cast(int, v), 0xB1, 0xF, 0xF, false));
  v += __builtin_bit_cast(float, __builtin_amdgcn_update_dpp(0, __builtin_bit_cast(int, v), 0x4E, 0xF, 0xF, false));
  v += __builtin_bit_cast(float, __builtin_amdgcn_update_dpp(0, __builtin_bit_cast(int, v), 0x141, 0xF, 0xF, false));
  v += __builtin_bit_cast(float, __builtin_amdgcn_update_dpp(0, __builtin_bit_cast(int, v), 0x140, 0xF, 0xF, false));
  return v;
}
DI unsigned mkkey(float f, int c) { unsigned u = __float_as_uint(f); u = (u >> 31) ? ~u : (u | 0x80000000u); return (u & 0xFFFFFF00u) | (unsigned)(255 - c); }
DI float keyval(unsigned k) { const unsigned u = k & 0xFFFFFF00u; return __uint_as_float((u >> 31) ? (u & 0x7FFFFFFFu) : ~u); }
DI int keyidx(unsigned k) { return 255 - (int)(k & 255u); }
DI void ce_desc(unsigned& a, unsigned& b) { const unsigned hi = max(a, b), lo = min(a, b); a = hi; b = lo; }
DI void sort8_desc(unsigned (&k)[8]) {
  ce_desc(k[0], k[1]); ce_desc(k[2], k[3]); ce_desc(k[4], k[5]); ce_desc(k[6], k[7]);
  ce_desc(k[0], k[2]); ce_desc(k[1], k[3]); ce_desc(k[4], k[6]); ce_desc(k[5], k[7]);
  ce_desc(k[1], k[2]); ce_desc(k[5], k[6]);
  ce_desc(k[0], k[4]); ce_desc(k[1], k[5]); ce_desc(k[2], k[6]); ce_desc(k[3], k[7]);
  ce_desc(k[2], k[4]); ce_desc(k[3], k[5]);
  ce_desc(k[1], k[2]); ce_desc(k[3], k[4]); ce_desc(k[5], k[6]);
}
DI unsigned top16_sorted8(unsigned (&k)[8], int l16) {
  unsigned res = 0;
  for (int rnd = 0; rnd < 16; ++rnd) {
    const unsigned m = dpp_max_row(k[0]);
    if (l16 == rnd) res = m;
    const bool win = (k[0] == m);
#pragma unroll
    for (int s = 0; s < 7; ++s) k[s] = win ? k[s + 1] : k[s];
    k[7] = win ? 0u : k[7];
  }
  return res;
}

DI void pop_round(unsigned (&k)[8], unsigned& res, int l16, int rnd) {
  const unsigned m = dpp_max_row(k[0]);
  if (l16 == rnd) res = m;
  const bool win = (k[0] == m);
#pragma unroll
  for (int s = 0; s < 7; ++s) k[s] = win ? k[s + 1] : k[s];
  k[7] = win ? 0u : k[7];
}

DI void peer_select(const Params& p, int tile, int hd, char* smem, bool load_keys) {
  u16* sK1 = (u16*)smem;
  u16* sK2 = sK1 + 128 * 136;
  u16* sQ = sK2 + 128 * 136;
  float* sS = (float*)(sQ + 64 * 264);
  int tid = threadIdx.x;
  asm volatile("" : "+v"(tid));
  char* ws = p.ws;
  float* outp = p.out;
  asm volatile("" : "+s"(ws), "+s"(outp));
  const int lane = tid & 63, wid = tid >> 6, r = lane & 31, h = lane >> 5;
  const u16* QP = (const u16*)(ws + OFF_QP);
  const u16* K12 = (const u16*)(ws + OFF_K12);
  const int tok0 = tile * 64;
  for (int e = tid; e < 64 * 32; e += NTHR) {
    const int n = e >> 5, g = e & 31;
    *(uint4*)(sQ + n * 264 + g * 8) = *(const uint4*)(QP + (size_t)(tok0 + n) * 2048 + hd * 256 + g * 8);
  }
  if (load_keys) {
    for (int e = tid; e < 2 * 128 * 16; e += NTHR) {
      const int which = e >> 11, n = (e >> 4) & 127, g = e & 15;
      *(uint4*)(sK1 + which * 128 * 136 + n * 136 + g * 8) = *(const uint4*)(K12 + ((size_t)(which * 8 + hd) * 128 + n) * 128 + g * 8);
    }
  }
  __syncthreads();
  const int l16 = lane & 15, rowb = lane & 48;
  const int tl0 = wid * 8 + (lane >> 4), tl1 = tl0 + 4;
  unsigned ka[8], kb[8], kc[8], kd[8];
  {
    const int tt = wid >> 2, tk = wid & 3;
    f32x16 acc1, acc2;
#pragma unroll
    for (int i = 0; i < 16; ++i) { acc1[i] = 0.f; acc2[i] = 0.f; }
    mma_tile_vec<8>(acc1, sQ + (32 * tt) * 264, 264, sK1 + (32 * tk) * 136, 136, r, h);
    mma_tile_vec<8>(acc2, sQ + (32 * tt) * 264 + 128, 264, sK2 + (32 * tk) * 136, 136, r, h);
#pragma unroll
    for (int i = 0; i < 16; ++i) sS[(32 * tt + crow(i, h)) * 132 + 32 * tk + r] = acc1[i];
    __syncthreads();
#pragma unroll
    for (int s = 0; s < 8; ++s) { const int cc = s * 16 + l16; ka[s] = mkkey(sS[tl0 * 132 + cc], cc); kc[s] = mkkey(sS[tl1 * 132 + cc], cc); }
    __syncthreads();
#pragma unroll
    for (int i = 0; i < 16; ++i) sS[(32 * tt + crow(i, h)) * 132 + 32 * tk + r] = acc2[i];
    __syncthreads();
#pragma unroll
    for (int s = 0; s < 8; ++s) { const int cc = s * 16 + l16; kb[s] = mkkey(sS[tl0 * 132 + cc], cc); kd[s] = mkkey(sS[tl1 * 132 + cc], cc); }
  }
  int* EIDX = (int*)(ws + OFF_EIDX);
  float* GATE = (float*)(ws + OFF_GATE);
  {
    sort8_desc(ka); sort8_desc(kb); sort8_desc(kc); sort8_desc(kd);
    unsigned ra = 0, rb = 0, rc = 0, rd = 0;
    for (int rnd = 0; rnd < 16; ++rnd) {
      pop_round(ka, ra, l16, rnd); pop_round(kb, rb, l16, rnd); pop_round(kc, rc, l16, rnd); pop_round(kd, rd, l16, rnd);
    }
    const float v1[2] = {keyval(ra), keyval(rc)}, v2[2] = {keyval(rb), keyval(rd)};
    const int i1[2] = {keyidx(ra), keyidx(rc)}, i2[2] = {keyidx(rb), keyidx(rd)};
    int ptr[2] = {0, 0};
    unsigned hk[2], r3[2] = {0u, 0u};
#pragma unroll
    for (int gq = 0; gq < 2; ++gq) hk[gq] = mkkey(__shfl(v1[gq], rowb) + v2[gq], l16);
    for (int rnd = 0; rnd < 16; ++rnd) {
#pragma unroll
      for (int gq = 0; gq < 2; ++gq) {
        const unsigned m = dpp_max_row(hk[gq]);
        if (l16 == rnd) r3[gq] = m;
        ptr[gq] += (hk[gq] == m) ? 1 : 0;
        const float va = __shfl(v1[gq], rowb + (ptr[gq] & 15));
        hk[gq] = (ptr[gq] < 16) ? mkkey(va + v2[gq], ptr[gq] * 16 + l16) : 0u;
      }
    }
#pragma unroll
    for (int gq = 0; gq < 2; ++gq) {
      const int cc = keyidx(r3[gq]);
      const float sc = keyval(r3[gq]);
      const int ia = __shfl(i1[gq], rowb + (cc >> 4)), ib = __shfl(i2[gq], rowb + (cc & 15));
      const float mx = __shfl(sc, rowb);
      const float ex = __expf(sc - mx);
      const float sum = dpp_sum_row(ex);
      const size_t o = ((size_t)(tok0 + (gq ? tl1 : tl0)) * 8 + hd) * 16 + l16;
      EIDX[o] = ia * 128 + ib;
      GATE[o] = ex / sum;
    }
  }
  __syncthreads();
}

DI void unpack_fp8x16(const uint4& a, f32x2* f) {
  f[0] = __builtin_amdgcn_cvt_pk_f32_fp8((int)a.x, false); f[1] = __builtin_amdgcn_cvt_pk_f32_fp8((int)a.x, true);
  f[2] = __builtin_amdgcn_cvt_pk_f32_fp8((int)a.y, false); f[3] = __builtin_amdgcn_cvt_pk_f32_fp8((int)a.y, true);
  f[4] = __builtin_amdgcn_cvt_pk_f32_fp8((int)a.z, false); f[5] = __builtin_amdgcn_cvt_pk_f32_fp8((int)a.z, true);
  f[6] = __builtin_amdgcn_cvt_pk_f32_fp8((int)a.w, false); f[7] = __builtin_amdgcn_cvt_pk_f32_fp8((int)a.w, true);
}
DI float wave_sum_dpp(float v) {
  v = dpp_sum_row(v);
  const int b = __builtin_bit_cast(int, v);
  return __builtin_bit_cast(float, __builtin_amdgcn_readlane(b, 0)) + __builtin_bit_cast(float, __builtin_amdgcn_readlane(b, 16)) +
         __builtin_bit_cast(float, __builtin_amdgcn_readlane(b, 32)) + __builtin_bit_cast(float, __builtin_amdgcn_readlane(b, 48));
}
constexpr int GB8 = 16;
DI void phase8(const Params& p) {
  const int tid = threadIdx.x, lane = tid & 63;
  const int gw = blockIdx.x * (NTHR / 64) + (tid >> 6), nw = gridDim.x * (NTHR / 64);
  const u16* H2 = (const u16*)(p.ws + OFF_H2);
  const unsigned char* UB = (const unsigned char*)(p.ws + OFF_UB);
  const unsigned char* VB = (const unsigned char*)(p.ws + OFF_VB);
  const float* USC = (const float*)(p.ws + OFF_USC);
  const float* VSC = (const float*)(p.ws + OFF_VSC);
  const int* EIDX = (const int*)(p.ws + OFF_EIDX);
  const float* GATE = (const float*)(p.ws + OFF_GATE);
  for (int tok = gw; tok < T_ALL; tok += nw) {
    f32x2 hx[8];
    {
      float t[16];
      const uint4* hp = (const uint4*)(H2 + (size_t)tok * 1024 + lane * 16);
      unpack16(hp[0], hp[1], t);
      const float rsn = rsqrtf(((const float*)(p.ws + OFF_RSS))[tok] * (1.f / 1024.f) + 1e-6f);
#pragma unroll
      for (int j = 0; j < 8; ++j) { hx[j].x = t[2 * j] * rsn; hx[j].y = t[2 * j + 1] * rsn; }
    }
    const int e0 = EIDX[(size_t)tok * 128 + lane], e1 = EIDX[(size_t)tok * 128 + 64 + lane];
    const int g0 = __builtin_bit_cast(int, GATE[(size_t)tok * 128 + lane]), g1 = __builtin_bit_cast(int, GATE[(size_t)tok * 128 + 64 + lane]);
    f32x2 acc[8];
#pragma unroll
    for (int j = 0; j < 8; ++j) { acc[j].x = 0.f; acc[j].y = 0.f; }
    for (int rp = 0; rp < REP_P8; ++rp) {
#pragma unroll
    for (int j = 0; j < 8; ++j) { acc[j].x = 0.f; acc[j].y = 0.f; }
    for (int j0 = 0; j0 < 128; j0 += GB8) {
      const int ee = (j0 < 64) ? e0 : e1, gg = (j0 < 64) ? g0 : g1;
      uint4 uq[GB8], vq[GB8];
      float gt[GB8], us[GB8];
#pragma unroll
      for (int u = 0; u < GB8; ++u) {
        const int e = __builtin_amdgcn_readlane(ee, (j0 & 63) + u);
        const float g = __builtin_bit_cast(float, __builtin_amdgcn_readlane(gg, (j0 & 63) + u));
        uq[u] = *(const uint4*)(UB + (size_t)e * 1024 + lane * 16);
        vq[u] = *(const uint4*)(VB + (size_t)e * 1024 + lane * 16);
        gt[u] = g * VSC[e];
        us[u] = USC[e];
      }
#pragma unroll
      for (int u = 0; u < GB8; ++u) {
        f32x2 f[8];
        unpack_fp8x16(uq[u], f);
        f32x2 d2 = f[0] * hx[0];
#pragma unroll
        for (int j = 1; j < 8; ++j) d2 += f[j] * hx[j];
        float d = wave_sum_dpp(d2.x + d2.y) * us[u];
        const float z = 1.5957691216057308f * (d + 0.044715f * d * d * d);
        const float act = d * __builtin_amdgcn_rcpf(1.f + __expf(-z));
        const float wgt = gt[u] * act;
        unpack_fp8x16(vq[u], f);
#pragma unroll
        for (int j = 0; j < 8; ++j) acc[j] += f[j] * wgt;
      }
    }
    }
    float* yr = p.out + OUT_Y + (size_t)tok * 1024 + lane * 16;
    float y[16], ss = 0.f;
#pragma unroll
    for (int q = 0; q < 4; ++q) {
      const float4 xv = ((const float4*)yr)[q];
      y[4 * q] = xv.x + acc[2 * q].x; y[4 * q + 1] = xv.y + acc[2 * q].y; y[4 * q + 2] = xv.z + acc[2 * q + 1].x; y[4 * q + 3] = xv.w + acc[2 * q + 1].y;
    }
#pragma unroll
    for (int j = 0; j < 16; ++j) ss += y[j] * y[j];
    ss = wave_sum(ss);
    const float rs = rsqrtf(ss * (1.f / 1024.f) + 1e-6f);
#pragma unroll
    for (int q = 0; q < 4; ++q) {
      const float4 ww = ((const float4*)(p.norm_final_w + lane * 16))[q];
      float4 o;
      o.x = y[4 * q] * rs * ww.x; o.y = y[4 * q + 1] * rs * ww.y; o.z = y[4 * q + 2] * rs * ww.z; o.w = y[4 * q + 3] * rs * ww.w;
      ((float4*)yr)[q] = o;
    }
  }
}


#define XB_TMO      128
#define XB_XCNT(j)  (256  + 64 * (j))
#define XB_XSUB(j)  (1280 + 64 * (j))
#define XB_XGEN(j)  (2304 + 64 * (j))
#define XB_TOP      3328
#define XB_TOPGEN   3392
#define XCD_BAR_WORDS 3456
#define XB_SPIN_CAP (1u << 18)
#define LAS __attribute__((address_space(3)))
DI unsigned xb_ld(unsigned* p) { return __hip_atomic_load(p, __ATOMIC_RELAXED, __HIP_MEMORY_SCOPE_AGENT); }
DI unsigned xb_add(unsigned* p, unsigned v) { return __hip_atomic_fetch_add(p, v, __ATOMIC_RELAXED, __HIP_MEMORY_SCOPE_AGENT); }
DI unsigned xb_xcc_id() { return (unsigned)__builtin_amdgcn_s_getreg((3 << 11) | 20) & 0xFu; }
#define XB_SPIN(cond, bar) do { unsigned _sp = 0; while (cond) { __builtin_amdgcn_s_sleep(1); \
    if ((++_sp & 255u) == 0u) { if (xb_ld(&(bar)[XB_TMO])) break; if (_sp > XB_SPIN_CAP) { atomicAdd(&(bar)[XB_TMO], 1u); break; } } } } while (0)
struct XcdBarrier { unsigned* bar; unsigned x; volatile LAS unsigned* st; };
DI XcdBarrier xcd_barrier_post(unsigned* bar, volatile LAS unsigned* st) {
  XcdBarrier b; b.bar = bar; b.x = xb_xcc_id(); b.st = st;
  if (threadIdx.x == 0) (void)xb_add(&bar[XB_XCNT(b.x)], 1u);
  return b;
}
DI void xcd_barrier_complete(unsigned* bar, unsigned x, unsigned& nloc, unsigned& nx) {
  const unsigned G = gridDim.x * gridDim.y * gridDim.z;
  unsigned sum, cnt, mine, sp = 0u;
  for (;;) {
    sum = 0u; cnt = 0u; mine = 0u;
#pragma unroll
    for (unsigned j = 0; j < 16; ++j) { const unsigned c = xb_ld(&bar[XB_XCNT(j)]); sum += c; cnt += (c > 0u) ? 1u : 0u; mine = (j == x) ? c : mine; }
    if (sum == G) break;
    __builtin_amdgcn_s_sleep(1);
    if ((++sp & 255u) == 0u) { if (xb_ld(&bar[XB_TMO])) break; if (sp > XB_SPIN_CAP) { atomicAdd(&bar[XB_TMO], 1u); break; } }
  }
  nloc = mine > 0u ? mine : 1u; nx = cnt > 0u ? cnt : 1u;
}
DI void xcd_barrier(const XcdBarrier& b) {
  asm volatile("s_waitcnt vmcnt(0)" ::: "memory");
  __syncthreads();
  if (threadIdx.x == 0) {
    unsigned* bar = b.bar;
    __builtin_amdgcn_s_waitcnt(0);
    unsigned nloc = b.st[0], nx = b.st[1];
    if (nloc == 0u) { xcd_barrier_complete(bar, b.x, nloc, nx); b.st[0] = nloc; b.st[1] = nx; }
    const unsigned old = xb_add(&bar[XB_XSUB(b.x)], 1u);
    const unsigned gen = old / nloc;
    if (old + 1u == (gen + 1u) * nloc) {
      __builtin_amdgcn_fence(__ATOMIC_RELEASE, "agent");
      asm volatile("s_waitcnt vmcnt(0)" ::: "memory");
      const unsigned og = xb_add(&bar[XB_TOP], 1u);
      const unsigned tg = og / nx;
      if (og + 1u == (tg + 1u) * nx) xb_add(&bar[XB_TOPGEN], 1u);
      else XB_SPIN(xb_ld(&bar[XB_TOPGEN]) == tg, bar);
      __builtin_amdgcn_fence(__ATOMIC_ACQUIRE, "agent");
      xb_add(&bar[XB_XGEN(b.x)], 1u);
      asm volatile("s_waitcnt vmcnt(0)" ::: "memory");
    } else {
      XB_SPIN(xb_ld(&bar[XB_XGEN(b.x)]) == gen, bar);
      __builtin_amdgcn_fence(__ATOMIC_ACQUIRE, "agent");
      asm volatile("s_waitcnt vmcnt(0)" ::: "memory");
    }
  }
  __syncthreads();
}

__global__ void __launch_bounds__(NTHR) mega(Params p) {
  extern __shared__ __attribute__((aligned(16))) char smem[];
  cg::grid_group grid = cg::this_grid();
  __shared__ uint4 xb_words;
  if (threadIdx.x == 0) xb_words = make_uint4(0u, 0u, 0u, 0u);
  __syncthreads();
  if (blockIdx.x == 0) for (int i = threadIdx.x; i < XCD_BAR_WORDS; i += NTHR) ((unsigned*)(p.ws + OFF_BAR))[i] = 0u;
  phase0(p);
  grid.sync();
  const XcdBarrier xb = xcd_barrier_post((unsigned*)(p.ws + OFF_BAR), (volatile LAS unsigned*)&xb_words);
#if REP_P0 > 1
  phase0(p);
  xcd_barrier(xb);
#endif
  for (int rp = 0; rp < REP_P1; ++rp) {
    u16* PGLA = (u16*)(p.ws + OFF_PGLA); u16* PGATE = (u16*)(p.ws + OFF_PGATE); u16* PGDN = (u16*)(p.ws + OFF_PGDN);
    float* PSM = p.out + OOFF_PSMALL;
    gemm_phase((const u16*)(p.ws + OFF_R1), (const u16*)(p.ws + OFF_WIN), 3712,
               [&](int row, int col, const f32x16 (&acc)[2][2]) {
                 const int ct = col & ~127;
                 if (ct < 1024) store_tile_bf16<1024>(PGLA + (size_t)row * 1024 + col, acc);
                 else if (ct < 2048) store_tile_bf16<1024>(PGATE + (size_t)row * 1024 + (col - 1024), acc);
                 else if (ct < 3584) store_tile_bf16<1536>(PGDN + (size_t)row * 1536 + (col - 2048), acc);
                 else if (col < 3616) {
#pragma unroll
                   for (int mi = 0; mi < 2; ++mi)
#pragma unroll
                     for (int i = 0; i < 16; ++i) PSM[(size_t)(row + mi * 32 + (i & 3) + 8 * (i >> 2)) * 32 + (col - 3584)] = acc[mi][0][i];
                 }
               }, smem);
    xcd_barrier(xb);
  }
  conv_state_out(p);
  for (int rp = 0; rp < REP_P2L; ++rp) {
    for (int u = blockIdx.x; u < NCH; u += gridDim.x) gla_prep(p, u >> 2, u & 3, smem);
    if (rp + 1 < REP_P2L) xcd_barrier(xb);
  }
  for (int rp = 0; rp < REP_P2G; ++rp) {
    for (int u = gridDim.x - 1 - blockIdx.x; u < NCH; u += gridDim.x) gdn_prep(p, u >> 2, u & 3, smem);
    if (rp + 1 < REP_P2G) xcd_barrier(xb);
  }
  xcd_barrier(xb);
  phase3(p, smem);
  xcd_barrier(xb);
  for (int u = GLA_OUT_EARLY + blockIdx.x; u < NCH; u += gridDim.x) gla_out(p, u >> 2, u & 3, smem);
  for (int rp = 0; rp < REP_P4B; ++rp) {
    phase4_misc(p);
    xcd_barrier(xb);
  }
  for (int rp = 0; rp < REP_P5; ++rp) {
    float* X1 = p.out + OUT_Y;
    u16* H2u = (u16*)(p.ws + OFF_H2);
    float* RSS = (float*)(p.ws + OFF_RSS);
    gemm_phase((const u16*)(p.ws + OFF_O), (const u16*)(p.ws + OFF_WOUT), 1024,
               [&](int row, int col, const f32x16 (&acc)[2][2]) {
                 float* q0 = X1 + (size_t)row * 1024 + col;
                 const float* x0 = xrow(p, row) + col;
                 u16* h0 = H2u + (size_t)row * 1024 + col;
                 const float wf0 = p.norm_ffn_w[col], wf1 = p.norm_ffn_w[col + 32];
                 const int lane_ = threadIdx.x & 63;
#pragma unroll
                 for (int mi = 0; mi < 2; ++mi)
#pragma unroll
                   for (int g = 0; g < 4; ++g)
#pragma unroll
                     for (int j = 0; j < 4; ++j) {
                       size_t off = (size_t)(mi * 32 + 8 * g + j) * 1024;
                       asm volatile("" : "+v"(off));
                       const float v0 = x0[off] + acc[mi][0][4 * g + j], v1 = x0[off + 32] + acc[mi][1][4 * g + j];
                       q0[off] = v0; q0[off + 32] = v1;
                       h0[off] = f2bf(v0 * wf0); h0[off + 32] = f2bf(v1 * wf1);
                       float sq = dpp_sum_row(v0 * v0 + v1 * v1);
                       sq += __shfl_xor(sq, 16);
                       if ((lane_ & 31) == 0) atomicAdd(RSS + row + mi * 32 + 8 * g + j, sq);
                     }
               }, smem);
  xcd_barrier(xb);
  }
  for (int rp = 0; rp < REP_P6; ++rp) {
    u16* QP = (u16*)(p.ws + OFF_QP);
    gemm_phase((const u16*)(p.ws + OFF_H2), (const u16*)(p.ws + OFF_WQ), 2048,
               [&](int row, int col, const f32x16 (&acc)[2][2]) {
                 const float* RSS = (const float*)(p.ws + OFF_RSS);
#pragma unroll
                 for (int mi = 0; mi < 2; ++mi)
#pragma unroll
                   for (int g = 0; g < 4; ++g)
#pragma unroll
                     for (int j = 0; j < 4; ++j) {
                       const int rr = row + mi * 32 + 8 * g + j;
                       const float rs = rsqrtf(RSS[rr] * (1.f / 1024.f) + 1e-6f);
                       u16* q = QP + (size_t)rr * 2048 + col;
                       asm volatile("" : "+v"(q));
                       q[0] = f2bf(acc[mi][0][4 * g + j] * rs);
                       q[32] = f2bf(acc[mi][1][4 * g + j] * rs);
                     }
               }, smem);
  xcd_barrier(xb);
  }
  for (int rp = 0; rp < REP_P7; ++rp) {
    int khd = -1;
    for (int u = blockIdx.x; u < 520 * 8; u += gridDim.x) { peer_select(p, u >> 3, u & 7, smem, (u & 7) != khd); khd = u & 7; }
    xcd_barrier(xb);
  }
#ifdef REP_SYNC
  for (int i = 0; i < REP_SYNC; ++i) xcd_barrier(xb);
#endif
  phase8(p);
}

extern "C" void kernel_launch(void* const* d_in, const int* in_sizes, int n_in, void* d_out, int out_size, void* d_ws,
                              size_t ws_size, hipStream_t stream) {
  static int grid_blocks = 0;
  if (!grid_blocks) {
    int dev = 0, cus = 0, per_cu = 0;
    (void)hipGetDevice(&dev);
    (void)hipDeviceGetAttribute(&cus, hipDeviceAttributeMultiprocessorCount, dev);
    (void)hipFuncSetAttribute((const void*)mega, hipFuncAttributeMaxDynamicSharedMemorySize, (int)LDS_BYTES);
    (void)hipOccupancyMaxActiveBlocksPerMultiprocessor(&per_cu, mega, NTHR, LDS_BYTES);
    if (per_cu < 1) per_cu = 1;
    grid_blocks = cus * per_cu;
    if (ws_size < WS_NEED) fprintf(stderr, "workspace too small: %zu < %zu\n", ws_size, (size_t)WS_NEED);
  }
  Params p{};
  const float** pp = (const float**)&p;
  for (int i = 0; i < 22; ++i) pp[i] = (const float*)d_in[i];
  p.out = (float*)d_out;
  p.ws = (char*)d_ws;
  void* args[] = {&p};
  hipError_t e = hipLaunchCooperativeKernel((void*)mega, dim3(grid_blocks), dim3(NTHR), args, LDS_BYTES, stream);
  if (e != hipSuccess) fprintf(stderr, "cooperative launch failed: %s (grid %d)\n", hipGetErrorString(e), grid_blocks);
}
```

```cpp
#include <hip/hip_runtime.h>
#include <hip/hip_cooperative_groups.h>
#include <cstdio>
#include <cstdint>
namespace cg = cooperative_groups;

#define DI __device__ __forceinline__
typedef unsigned short u16;
typedef short bf16x8 __attribute__((ext_vector_type(8)));
typedef float f32x16 __attribute__((ext_vector_type(16)));
typedef float f32x2 __attribute__((ext_vector_type(2)));
typedef __bf16 bf16x2_t __attribute__((ext_vector_type(2)));
typedef unsigned u32x4 __attribute__((ext_vector_type(4)));

#ifndef REP_P0
#define REP_P0 1
#endif
#ifndef REP_P1
#define REP_P1 1
#endif
#ifndef REP_P2G
#define REP_P2G 1
#endif
#ifndef REP_P2L
#define REP_P2L 1
#endif
#ifndef REP_P3G
#define REP_P3G 1
#endif
#ifndef REP_P4A
#define REP_P4A 1
#endif
#ifndef REP_P4B
#define REP_P4B 1
#endif
#ifndef REP_P5
#define REP_P5 1
#endif
#ifndef REP_P6
#define REP_P6 1
#endif
#ifndef REP_P8
#define REP_P8 1
#endif
#ifndef REP_P7
#define REP_P7 1
#endif
constexpr int NTHR = 512;
constexpr int T_ALL = 33280, T_P = 32768;
constexpr int NCH = 2112;
constexpr size_t LDS_BYTES = 147456;

constexpr size_t OFF_WIN = 0;
constexpr size_t OFF_WOUT = OFF_WIN + 3840ull * 1024 * 2;
constexpr size_t OFF_WQ = OFF_WOUT + 1024ull * 1024 * 2;
constexpr size_t OFF_K12 = OFF_WQ + 2048ull * 1024 * 2;
constexpr size_t OFF_R1 = OFF_K12 + 2ull * 8 * 128 * 128 * 2;
constexpr size_t OFF_R2 = OFF_R1 + (size_t)T_ALL * 1024 * 2;
constexpr size_t OFF_PGLA = OFF_R2;
constexpr size_t OFF_PGATE = OFF_PGLA + (size_t)T_ALL * 1024 * 2;
constexpr size_t OFF_PGDN = OFF_PGATE + (size_t)T_ALL * 1024 * 2;
constexpr size_t OFF_R3 = OFF_PGDN + (size_t)T_ALL * 1536 * 2;
constexpr size_t OFF_GI = OFF_R3;
constexpr size_t OFF_GDEC = OFF_GI + (size_t)NCH * 98304;
constexpr size_t OFF_BAR = (OFF_GDEC + NCH * 4 + 255) / 256 * 256;
constexpr size_t OFF_RSS = OFF_BAR + 14080;
constexpr size_t WS_NEED = OFF_RSS + (size_t)T_ALL * 4;
constexpr size_t OFF_QP = OFF_R2;
constexpr size_t OFF_EIDX = OFF_PGDN;
constexpr size_t OFF_GATE = OFF_EIDX + (size_t)T_ALL * 128 * 4;
constexpr size_t OFF_O = OFF_PGDN;
constexpr size_t OFF_UB = OFF_R1 + (size_t)T_ALL * 512 * 2;
constexpr size_t OFF_H2 = OFF_R3 + 64ull * 1048576;
constexpr size_t OFF_VB = OFF_UB + 16384ull * 1024;
constexpr size_t OFF_USC = OFF_VB + 16384ull * 1024;
constexpr size_t OFF_VSC = OFF_USC + 16384ull * 4;
constexpr size_t OOFF_GB = 0;
constexpr size_t OOFF_GLD = OOFF_GB + (size_t)NCH * 8192;
constexpr size_t OOFF_PSMALL = OOFF_GLD + (size_t)NCH * 64;
constexpr size_t OUT_Y = 0;
constexpr size_t OUT_GLA_P = (size_t)T_ALL * 1024;
constexpr size_t OUT_GDN_P = OUT_GLA_P + 4 * 4 * 64 * 128;
constexpr size_t OUT_CONV_P = OUT_GDN_P + 4 * 4 * 128 * 128;
constexpr size_t OUT_GLA_S = OUT_CONV_P + 4 * 3 * 1536;
constexpr size_t OUT_GDN_S = OUT_GLA_S + 16 * 4 * 64 * 128;
constexpr size_t OUT_CONV_S = OUT_GDN_S + 16 * 4 * 128 * 128;

struct Params {
  const float *x_prompt, *x_sample, *state_gla, *state_gdn, *state_conv, *norm_mix_w, *w_in, *gla_w_gk2, *gla_b_gk,
      *gla_norm_w, *gdn_conv_w, *gdn_a_log, *gdn_dt_bias, *gdn_norm_w, *w_out, *norm_ffn_w, *peer_wq, *peer_k1, *peer_k2,
      *peer_u, *peer_v, *norm_final_w;
  float* out;
  char* ws;
};

DI unsigned pk2(float a, float b) { f32x2 v = {a, b}; bf16x2_t r = __builtin_convertvector(v, bf16x2_t); return __builtin_bit_cast(unsigned, r); }
DI u16 f2bf(float a) { return (u16)(pk2(a, 0.f) & 0xffffu); }
DI float bf2f(u16 v) { return __uint_as_float(((unsigned)v) << 16); }
DI float bflo(unsigned v) { return __uint_as_float(v << 16); }
DI float bfhi(unsigned v) { return __uint_as_float(v & 0xffff0000u); }
DI int crow(int reg, int h) { return (reg & 3) + 8 * (reg >> 2) + 4 * h; }
DI float wave_sum(float v) {
#pragma unroll
  for (int o = 32; o > 0; o >>= 1) v += __shfl_xor(v, o);
  return v;
}
DI float sigmoidf_(float x) { return __builtin_amdgcn_rcpf(1.f + __expf(-x)); }
DI float softplusf_(float x) { return x > 20.f ? x : log1pf(__expf(x)); }
DI const float* xrow(const Params& p, int tok) { return tok < T_P ? p.x_prompt + (size_t)tok * 1024 : p.x_sample + (size_t)(tok - T_P) * 1024; }
DI bf16x8 pack8(const f32x16& x, int s) {
  u32x4 q;
  q.x = pk2(x[8 * s + 0], x[8 * s + 1]); q.y = pk2(x[8 * s + 2], x[8 * s + 3]);
  q.z = pk2(x[8 * s + 4], x[8 * s + 5]); q.w = pk2(x[8 * s + 6], x[8 * s + 7]);
  return __builtin_bit_cast(bf16x8, q);
}
#define LDS_BARRIER() do { asm volatile("s_waitcnt lgkmcnt(0)" ::: "memory"); __builtin_amdgcn_s_barrier(); asm volatile("" ::: "memory"); } while (0)
#define MFMA(a, b, c) __builtin_amdgcn_mfma_f32_32x32x16_bf16((a), (b), (c), 0, 0, 0)

template <int KSTEPS, class FA, class FB>
DI void mma_tile(f32x16& acc, FA fa, FB fb, int r, int h) {
#pragma unroll
  for (int s = 0; s < KSTEPS; ++s) {
    bf16x8 a, b;
#pragma unroll
    for (int j = 0; j < 8; ++j) {
      const int k = 16 * s + 8 * h + j;
      a[j] = (short)fa(r, k);
      b[j] = (short)fb(k, r);
    }
    acc = MFMA(a, b, acc);
  }
}

template <int KSTEPS>
DI void mma_tile_vec(f32x16& acc, const u16* A, int lda, const u16* B, int ldb, int r, int h) {
#pragma unroll
  for (int s = 0; s < KSTEPS; ++s) {
    const bf16x8 a = *(const bf16x8*)(A + r * lda + 16 * s + 8 * h);
    const bf16x8 b = *(const bf16x8*)(B + r * ldb + 16 * s + 8 * h);
    acc = MFMA(a, b, acc);
  }
}

DI void unpack16(const uint4& a, const uint4& b, float* f) {
  f[0] = bflo(a.x); f[1] = bfhi(a.x); f[2] = bflo(a.y); f[3] = bfhi(a.y); f[4] = bflo(a.z); f[5] = bfhi(a.z); f[6] = bflo(a.w); f[7] = bfhi(a.w);
  f[8] = bflo(b.x); f[9] = bfhi(b.x); f[10] = bflo(b.y); f[11] = bfhi(b.y); f[12] = bflo(b.z); f[13] = bfhi(b.z); f[14] = bflo(b.w); f[15] = bfhi(b.w);
}

DI int win_orig_col(int n) {
  if (n < 1024) return n;
  if (n < 1536) return 1040 + (n - 1024);
  if (n < 2048) return 3096 + (n - 1536);
  if (n < 3584) return 1552 + (n - 2048);
  if (n < 3600) return 1024 + (n - 3584);
  if (n < 3604) return 3088 + (n - 3600);
  if (n < 3608) return 3092 + (n - 3604);
  return -1;
}

DI void transpose_w(const float* __restrict__ w, int ncols_src, int n_dst, bool permute, u16* __restrict__ dst, int gtid, int gn) {
  const int items = n_dst * 128;
  for (int it = gtid; it < items; it += gn) {
    const int n = it % n_dst, kg = it / n_dst;
    const int oc = permute ? win_orig_col(n) : n;
    unsigned q[4];
#pragma unroll
    for (int j = 0; j < 4; ++j) {
      float a = 0.f, b = 0.f;
      if (oc >= 0) { a = w[(size_t)(kg * 8 + 2 * j) * ncols_src + oc]; b = w[(size_t)(kg * 8 + 2 * j + 1) * ncols_src + oc]; }
      q[j] = pk2(a, b);
    }
    *(uint4*)(dst + (size_t)n * 1024 + kg * 8) = make_uint4(q[0], q[1], q[2], q[3]);
  }
}

template <class RowF>
DI void norm_rows(RowF rowf, const float* __restrict__ w, u16* __restrict__ dst) {
  const int lane = threadIdx.x & 63;
  const int gw = blockIdx.x * (NTHR / 64) + (threadIdx.x >> 6), nw = gridDim.x * (NTHR / 64);
  float4 ww[4];
#pragma unroll
  for (int q = 0; q < 4; ++q) ww[q] = ((const float4*)w)[lane + 64 * q];
  for (int tok = gw; tok < T_ALL; tok += 2 * nw) {
    const int tok2 = tok + nw;
    const bool has2 = tok2 < T_ALL;
    const float4* xr = (const float4*)rowf(tok);
    const float4* xr2 = (const float4*)rowf(has2 ? tok2 : tok);
    float4 v[4], v2[4];
    float ss = 0.f, ss2 = 0.f;
#pragma unroll
    for (int q = 0; q < 4; ++q) { v[q] = xr[lane + 64 * q]; v2[q] = xr2[lane + 64 * q]; }
#pragma unroll
    for (int q = 0; q < 4; ++q) {
      ss += v[q].x * v[q].x + v[q].y * v[q].y + v[q].z * v[q].z + v[q].w * v[q].w;
      ss2 += v2[q].x * v2[q].x + v2[q].y * v2[q].y + v2[q].z * v2[q].z + v2[q].w * v2[q].w;
    }
#pragma unroll
    for (int o = 32; o > 0; o >>= 1) { ss += __shfl_xor(ss, o); ss2 += __shfl_xor(ss2, o); }
    const float rs = rsqrtf(ss * (1.f / 1024.f) + 1e-6f), rs2 = rsqrtf(ss2 * (1.f / 1024.f) + 1e-6f);
#pragma unroll
    for (int q = 0; q < 4; ++q) {
      uint2 o;
      o.x = pk2(v[q].x * rs * ww[q].x, v[q].y * rs * ww[q].y);
      o.y = pk2(v[q].z * rs * ww[q].z, v[q].w * rs * ww[q].w);
      *(uint2*)(dst + (size_t)tok * 1024 + 4 * (lane + 64 * q)) = o;
      if (has2) {
        uint2 o2;
        o2.x = pk2(v2[q].x * rs2 * ww[q].x, v2[q].y * rs2 * ww[q].y);
        o2.y = pk2(v2[q].z * rs2 * ww[q].z, v2[q].w * rs2 * ww[q].w);
        *(uint2*)(dst + (size_t)tok2 * 1024 + 4 * (lane + 64 * q)) = o2;
      }
    }
  }
}

DI void convert_f32_bf16(const float* __restrict__ src, u16* __restrict__ dst, size_t n4, int gtid, int gn) {
  for (size_t i = gtid; i < n4; i += gn) {
    const float4 v = ((const float4*)src)[i];
    uint2 o; o.x = pk2(v.x, v.y); o.y = pk2(v.z, v.w);
    ((uint2*)dst)[i] = o;
  }
}

DI void convert_rows_fp8(const float* __restrict__ src, unsigned char* __restrict__ dst, float* __restrict__ sc, int gw, int nw) {
  const int lane = threadIdx.x & 63;
  for (int row = gw; row < 16384; row += nw) {
    const float4* rp = (const float4*)(src + (size_t)row * 1024 + lane * 16);
    float4 v[4];
    float am = 0.f;
#pragma unroll
    for (int q = 0; q < 4; ++q) { v[q] = rp[q]; am = fmaxf(am, fmaxf(fmaxf(fabsf(v[q].x), fabsf(v[q].y)), fmaxf(fabsf(v[q].z), fabsf(v[q].w)))); }
#pragma unroll
    for (int o = 32; o > 0; o >>= 1) am = fmaxf(am, __shfl_xor(am, o));
    const float s = am > 0.f ? 256.f / am : 1.f;
    unsigned w[4];
#pragma unroll
    for (int q = 0; q < 4; ++q) {
      int t = 0;
      t = __builtin_amdgcn_cvt_pk_fp8_f32(v[q].x * s, v[q].y * s, t, false);
      t = __builtin_amdgcn_cvt_pk_fp8_f32(v[q].z * s, v[q].w * s, t, true);
      w[q] = (unsigned)t;
    }
    *(uint4*)(dst + (size_t)row * 1024 + lane * 16) = make_uint4(w[0], w[1], w[2], w[3]);
    if (lane == 0) sc[row] = am > 0.f ? am * (1.f / 256.f) : 1.f;
  }
}

DI void phase0(const Params& p) {
  const int gtid = blockIdx.x * NTHR + threadIdx.x, gn = gridDim.x * NTHR;
  transpose_w(p.w_in, 3608, 3840, true, (u16*)(p.ws + OFF_WIN), gtid, gn);
  transpose_w(p.w_out, 1024, 1024, false, (u16*)(p.ws + OFF_WOUT), gtid, gn);
  transpose_w(p.peer_wq, 2048, 2048, false, (u16*)(p.ws + OFF_WQ), gtid, gn);
  convert_f32_bf16(p.peer_k1, (u16*)(p.ws + OFF_K12), 8 * 128 * 128 / 4, gtid, gn);
  convert_f32_bf16(p.peer_k2, (u16*)(p.ws + OFF_K12) + 8 * 128 * 128, 8 * 128 * 128 / 4, gtid, gn);
  norm_rows([&](int tok) { return xrow(p, tok); }, p.norm_mix_w, (u16*)(p.ws + OFF_R1));
}

template <int LD>
DI void store_tile_bf16(u16* ptr, const f32x16 (&acc)[2][2]) {
#pragma unroll
  for (int mi = 0; mi < 2; ++mi)
#pragma unroll
    for (int g = 0; g < 4; ++g) {
#pragma unroll
      for (int j = 0; j < 4; ++j) {
        u16* q = ptr + (size_t)(mi * 32 + 8 * g + j) * LD;
        asm volatile("" : "+v"(q));
        q[0] = f2bf(acc[mi][0][4 * g + j]);
        q[32] = f2bf(acc[mi][1][4 * g + j]);
      }
    }
}

template <class Epi>
DI void gemm_phase(const u16* __restrict__ A, const u16* __restrict__ Bt, int N, Epi epi, char* smem) {
  constexpr int LS = 72;
  u16* sA0 = (u16*)smem;
  u16* sB0 = sA0 + 256 * LS;
  u16* sA1 = sB0 + 128 * LS;
  u16* sB1 = sA1 + 256 * LS;
  const int tid = threadIdx.x, lane = tid & 63, wid = tid >> 6, r = lane & 31, h = lane >> 5;
  const int wm = wid >> 1, wn = wid & 1;
  const int NTN = N / 128;
  const int ntiles = 130 * NTN;
  const int xcd = blockIdx.x & 7, cu = blockIdx.x >> 3, ncu = gridDim.x >> 3;
  auto tile_ptrs = [&](int tile, int& mt, int& nt) {
    const int grp = tile / (4 * NTN), idg = tile % (4 * NTN);
    const int gsz = (130 - grp * 4) < 4 ? (130 - grp * 4) : 4;
    mt = grp * 4 + idg % gsz; nt = idg / gsz;
  };
  uint4 p0, p1, p2, p3, p4, p5, q0, q1, q2, q3, q4, q5;
  const int so = (tid >> 3) * LS + (tid & 7) * 8;
  const size_t toff = (size_t)(tid >> 3) * 1024 + (tid & 7) * 8;
  bool first = true;
  for (int base = xcd * ncu; base < ntiles; base += 8 * ncu) {
    const int tile = base + cu;
    if (tile >= ntiles) break;
    int mt, nt, mtn, ntn;
    tile_ptrs(tile, mt, nt);
    const int tnext = (tile + 8 * ncu < ntiles) ? tile + 8 * ncu : tile;
    tile_ptrs(tnext, mtn, ntn);
    const u16* gA = A + (size_t)mt * 256 * 1024 + toff;
    const u16* gB = Bt + (size_t)nt * 128 * 1024 + toff;
    const u16* gAn = A + (size_t)mtn * 256 * 1024 + toff;
    const u16* gBn = Bt + (size_t)ntn * 128 * 1024 + toff;
    f32x16 acc[2][2];
#pragma unroll
    for (int a = 0; a < 2; ++a)
#pragma unroll
      for (int b = 0; b < 2; ++b)
#pragma unroll
        for (int i = 0; i < 16; ++i) acc[a][b][i] = 0.f;
#define GLOAD(a0, a1, a2, a3, b0, b1, pA, pB, kt)                                                          \
  {                                                                                                        \
    a0 = *(const uint4*)(pA + (kt) * 64); a1 = *(const uint4*)(pA + (kt) * 64 + 64 * 1024);                \
    a2 = *(const uint4*)(pA + (kt) * 64 + 128 * 1024); a3 = *(const uint4*)(pA + (kt) * 64 + 192 * 1024);  \
    b0 = *(const uint4*)(pB + (kt) * 64); b1 = *(const uint4*)(pB + (kt) * 64 + 64 * 1024);                \
  }
#define SSTORE(a0, a1, a2, a3, b0, b1, sA, sB)                                                             \
  {                                                                                                        \
    *(uint4*)((sA) + so) = a0; *(uint4*)((sA) + so + 64 * LS) = a1; *(uint4*)((sA) + so + 128 * LS) = a2;  \
    *(uint4*)((sA) + so + 192 * LS) = a3; *(uint4*)((sB) + so) = b0; *(uint4*)((sB) + so + 64 * LS) = b1;  \
  }
#define LDFR(fa, fb, cA, cB, ks)                                                                          \
  {                                                                                                        \
    _Pragma("unroll") for (int mi = 0; mi < 2; ++mi) fa[mi] = *(const bf16x8*)((cA) + (wm * 64 + mi * 32 + r) * LS + (ks) * 16 + h * 8); \
    _Pragma("unroll") for (int ni = 0; ni < 2; ++ni) fb[ni] = *(const bf16x8*)((cB) + (wn * 64 + ni * 32 + r) * LS + (ks) * 16 + h * 8); \
  }
#define MMA4(fa, fb)                                                                                       \
  {                                                                                                        \
    _Pragma("unroll") for (int mi = 0; mi < 2; ++mi)                                                       \
      _Pragma("unroll") for (int ni = 0; ni < 2; ++ni) acc[mi][ni] = MFMA(fa[mi], fb[ni], acc[mi][ni]);    \
  }
#define COMPUTE(cA, cB, x0, x1, x2, x3, x4, x5, oA, oB)                                                    \
  {                                                                                                        \
    bf16x8 fa0[2], fb0[2], fa1[2], fb1[2];                                                                 \
    LDFR(fa0, fb0, cA, cB, 0);                                                                             \
    LDFR(fa1, fb1, cA, cB, 1); __builtin_amdgcn_sched_barrier(0);                                          \
    *(uint4*)((oA) + so) = x0; *(uint4*)((oA) + so + 64 * LS) = x1;                                        \
    MMA4(fa0, fb0); __builtin_amdgcn_sched_barrier(0);                                                     \
    LDFR(fa0, fb0, cA, cB, 2);                                                                             \
    *(uint4*)((oA) + so + 128 * LS) = x2; *(uint4*)((oA) + so + 192 * LS) = x3; __builtin_amdgcn_sched_barrier(0); \
    MMA4(fa1, fb1); __builtin_amdgcn_sched_barrier(0);                                                     \
    LDFR(fa1, fb1, cA, cB, 3);                                                                             \
    *(uint4*)((oB) + so) = x4; *(uint4*)((oB) + so + 64 * LS) = x5; __builtin_amdgcn_sched_barrier(0);     \
    MMA4(fa0, fb0); __builtin_amdgcn_sched_barrier(0);                                                     \
    MMA4(fa1, fb1);                                                                                        \
  }
    if (first) {
      GLOAD(p0, p1, p2, p3, p4, p5, gA, gB, 0);
      GLOAD(q0, q1, q2, q3, q4, q5, gA, gB, 1);
      SSTORE(p0, p1, p2, p3, p4, p5, sA0, sB0);
      LDS_BARRIER();
      first = false;
    }
#pragma unroll 1
    for (int kt = 0; kt < 16; kt += 2) {
      const u16* sa = (kt < 14) ? gA : gAn;
      const u16* sb = (kt < 14) ? gB : gBn;
      const int k2 = (kt + 2) & 15;
      GLOAD(p0, p1, p2, p3, p4, p5, sa, sb, k2);
      __builtin_amdgcn_sched_barrier(0);
      COMPUTE(sA0, sB0, q0, q1, q2, q3, q4, q5, sA1, sB1);
      LDS_BARRIER();
      GLOAD(q0, q1, q2, q3, q4, q5, sa, sb, k2 + 1);
      __builtin_amdgcn_sched_barrier(0);
      COMPUTE(sA1, sB1, p0, p1, p2, p3, p4, p5, sA0, sB0);
      LDS_BARRIER();
    }
#undef COMPUTE
#undef LDFR
#undef MMA4
#undef GLOAD
#undef SSTORE
    epi(mt * 256 + wm * 64 + 4 * h, nt * 128 + wn * 64 + r, acc);
  }
}

template <int LD>
DI void store_tile4_bf16(u16* ptr, const f32x16 (&acc)[4][2]) {
#pragma unroll
  for (int mi = 0; mi < 4; ++mi)
#pragma unroll
    for (int g = 0; g < 4; ++g) {
#pragma unroll
      for (int j = 0; j < 4; ++j) {
        u16* q = ptr + (size_t)(mi * 32 + 8 * g + j) * LD;
        asm volatile("" : "+v"(q));
        q[0] = f2bf(acc[mi][0][4 * g + j]);
        q[32] = f2bf(acc[mi][1][4 * g + j]);
      }
    }
}
DI void gemm_in_phase(const Params& p, char* smem) {
  constexpr int LS = 72, NTN = 15, NTM = 130, GM = 4;
  u16* sA0 = (u16*)smem;
  u16* sB0 = sA0 + 256 * LS;
  u16* sA1 = sB0 + 256 * LS;
  u16* sB1 = sA1 + 256 * LS;
  const int tid = threadIdx.x, lane = tid & 63, wid = tid >> 6, r = lane & 31, h = lane >> 5;
  const int wm = wid >> 2, wn = wid & 3;
  const u16* A = (const u16*)(p.ws + OFF_R1);
  const u16* Bt = (const u16*)(p.ws + OFF_WIN);
  const int ntiles = NTM * NTN;
  const int xcd = blockIdx.x & 7, cu = blockIdx.x >> 3, ncu = gridDim.x >> 3;
  for (int base = xcd * ncu; base < ntiles; base += 8 * ncu) {
    const int id = base + cu;
    if (id >= ntiles) break;
    const int grp = id / (GM * NTN), idg = id % (GM * NTN);
    const int gsz = (NTM - grp * GM) < GM ? (NTM - grp * GM) : GM;
    const int mt = grp * GM + idg % gsz, nt = idg / gsz;
    const u16* Ab = A + (size_t)mt * 256 * 1024;
    const u16* Bb = Bt + (size_t)nt * 256 * 1024;
    f32x16 acc[4][2];
#pragma unroll
    for (int a = 0; a < 4; ++a)
#pragma unroll
      for (int b = 0; b < 2; ++b)
#pragma unroll
        for (int i = 0; i < 16; ++i) acc[a][b][i] = 0.f;
    uint4 a0, a1, a2, a3, b0, b1, b2, b3;
    const u16* gA = Ab + (size_t)(tid >> 3) * 1024 + (tid & 7) * 8;
    const u16* gB = Bb + (size_t)(tid >> 3) * 1024 + (tid & 7) * 8;
    const int so = (tid >> 3) * LS + (tid & 7) * 8;
#define GLOAD4(g, x0, x1, x2, x3, kt)                                                                      \
  {                                                                                                        \
    x0 = *(const uint4*)(g + (kt) * 64); x1 = *(const uint4*)(g + (kt) * 64 + 64 * 1024);                  \
    x2 = *(const uint4*)(g + (kt) * 64 + 128 * 1024); x3 = *(const uint4*)(g + (kt) * 64 + 192 * 1024);    \
  }
#define SSTORE4(x0, x1, x2, x3, sX)                                                                        \
  {                                                                                                        \
    *(uint4*)((sX) + so) = x0; *(uint4*)((sX) + so + 64 * LS) = x1; *(uint4*)((sX) + so + 128 * LS) = x2;  \
    *(uint4*)((sX) + so + 192 * LS) = x3;                                                                  \
  }
#define LDFR8(fa, fb, cA, cB, ks)                                                                         \
  {                                                                                                        \
    _Pragma("unroll") for (int mi = 0; mi < 4; ++mi) fa[mi] = *(const bf16x8*)((cA) + (wm * 128 + mi * 32 + r) * LS + (ks) * 16 + h * 8); \
    _Pragma("unroll") for (int ni = 0; ni < 2; ++ni) fb[ni] = *(const bf16x8*)((cB) + (wn * 64 + ni * 32 + r) * LS + (ks) * 16 + h * 8);  \
  }
#define MMA8(fa, fb)                                                                                       \
  {                                                                                                        \
    _Pragma("unroll") for (int mi = 0; mi < 4; ++mi)                                                       \
      _Pragma("unroll") for (int ni = 0; ni < 2; ++ni) acc[mi][ni] = MFMA(fa[mi], fb[ni], acc[mi][ni]);    \
  }
#define COMPUTE8(cA, cB)                                                                                   \
  {                                                                                                        \
    bf16x8 fa0[4], fb0[2], fa1[4], fb1[2];                                                                 \
    LDFR8(fa0, fb0, cA, cB, 0);                                                                            \
    LDFR8(fa1, fb1, cA, cB, 1); __builtin_amdgcn_sched_barrier(0);                                         \
    MMA8(fa0, fb0); __builtin_amdgcn_sched_barrier(0);                                                     \
    LDFR8(fa0, fb0, cA, cB, 2); __builtin_amdgcn_sched_barrier(0);                                         \
    MMA8(fa1, fb1); __builtin_amdgcn_sched_barrier(0);                                                     \
    LDFR8(fa1, fb1, cA, cB, 3); __builtin_amdgcn_sched_barrier(0);                                         \
    MMA8(fa0, fb0); __builtin_amdgcn_sched_barrier(0);                                                     \
    MMA8(fa1, fb1);                                                                                        \
  }
    GLOAD4(gA, a0, a1, a2, a3, 0);
    GLOAD4(gB, b0, b1, b2, b3, 0);
    SSTORE4(a0, a1, a2, a3, sA0);
    SSTORE4(b0, b1, b2, b3, sB0);
    LDS_BARRIER();
#pragma unroll 1
    for (int kt = 0; kt < 16; kt += 2) {
      GLOAD4(gA, a0, a1, a2, a3, kt + 1);
      GLOAD4(gB, b0, b1, b2, b3, kt + 1);
      __builtin_amdgcn_sched_barrier(0);
      COMPUTE8(sA0, sB0);
      SSTORE4(a0, a1, a2, a3, sA1);
      SSTORE4(b0, b1, b2, b3, sB1);
      LDS_BARRIER();
      GLOAD4(gA, a0, a1, a2, a3, kt + 2);
      GLOAD4(gB, b0, b1, b2, b3, kt + 2);
      __builtin_amdgcn_sched_barrier(0);
      COMPUTE8(sA1, sB1);
      SSTORE4(a0, a1, a2, a3, sA0);
      SSTORE4(b0, b1, b2, b3, sB0);
      LDS_BARRIER();
    }
#undef GLOAD4
#undef SSTORE4
#undef COMPUTE8
#undef LDFR8
#undef MMA8
    const int row = mt * 256 + wm * 128 + 4 * h, col = wn * 64 + r;
    if (nt < 4) store_tile4_bf16<1024>((u16*)(p.ws + OFF_PGLA) + (size_t)row * 1024 + nt * 256 + col, acc);
    else if (nt < 8) store_tile4_bf16<1024>((u16*)(p.ws + OFF_PGATE) + (size_t)row * 1024 + (nt - 4) * 256 + col, acc);
    else if (nt < 14) store_tile4_bf16<1536>((u16*)(p.ws + OFF_PGDN) + (size_t)row * 1536 + (nt - 8) * 256 + col, acc);
    else if (wn == 0) {
      float* PSM = p.out + OOFF_PSMALL;
#pragma unroll
      for (int mi = 0; mi < 4; ++mi)
#pragma unroll
        for (int i = 0; i < 16; ++i) PSM[(size_t)(row + mi * 32 + (i & 3) + 8 * (i >> 2)) * 32 + r] = acc[mi][0][i];
    }
  }
}

struct ChunkInfo { int tok0, valid, sample, seq, cl; };
DI ChunkInfo chunk_info(int c) {
  ChunkInfo ci;
  if (c < 512) { ci.tok0 = c * 64; ci.valid = 64; ci.sample = 0; ci.seq = c >> 7; ci.cl = c & 127; }
  else { ci.seq = c - 512; ci.tok0 = T_P + ci.seq * 32; ci.valid = 32; ci.sample = 1; ci.cl = 0; }
  return ci;
}

DI void gdn_prep(const Params& p, int c, int hd, char* smem) {
  constexpr int LD = 136, LT = 72;
  u16* sQ = (u16*)smem;
  u16* sK = sQ + 64 * LD;
  u16* sKbT = sK + 64 * LD;
  u16* sVbT = sKbT + 128 * LT;
  u16* sKtT = sVbT + 128 * LT;
  u16* sT = sKtT + 128 * LT;
  u16* sQK = sT + 64 * LT;
  float* sL = (float*)(sQK + 64 * LT);
  float* sG = sL + 64 * 68;
  float* sBe = sG + 64;
  float* sEk = sBe + 64;
  float* sEg = sEk + 64;
  float* sCW = sEg + 64;
  u16* sTT = (u16*)(sCW + 4 * 384);
  u16* sWT = sKbT;
  u16* sUT = sVbT;
  int tid = threadIdx.x;
  asm volatile("" : "+v"(tid));
  char* ws = p.ws;
  float* outp = p.out;
  asm volatile("" : "+s"(ws), "+s"(outp));
  const int lane = tid & 63, wid = tid >> 6, r = lane & 31, h = lane >> 5;
  const ChunkInfo ci = chunk_info(c);
  const int ch = c * 4 + hd;
  const u16* PGDN = (const u16*)(ws + OFF_PGDN);
  const float* PSM = outp + OOFF_PSMALL;
  if (wid == 0) {
    const int n = lane;
    float la = 0.f, be = 0.f;
    if (n < ci.valid) {
      const int tok = ci.tok0 + n;
      const float da = PSM[(size_t)tok * 32 + 16 + hd], db = PSM[(size_t)tok * 32 + 20 + hd];
      be = sigmoidf_(db);
      la = -__expf(p.gdn_a_log[hd]) * softplusf_(da + p.gdn_dt_bias[hd]);
    }
    float G = la;
#pragma unroll
    for (int off = 1; off < 64; off <<= 1) { const float t = __shfl_up(G, off); if (lane >= off) G += t; }
    const float glast = __shfl(G, 63);
    sG[n] = G; sBe[n] = be; sEk[n] = __expf(glast - G); sEg[n] = __expf(G);
    if (lane == 0) ((float*)(ws + OFF_GDEC))[ch] = __expf(glast);
  }
  for (int e = tid; e < 4 * 384; e += NTHR) {
    const int tap = e / 384, cc = e % 384;
    sCW[e] = p.gdn_conv_w[tap * 1536 + (cc >> 7) * 512 + hd * 128 + (cc & 127)];
  }
  {
    const int n = tid >> 3, g = tid & 7;
    uint4 raw[3][4][2];
#pragma unroll
    for (int part = 0; part < 3; ++part)
#pragma unroll
      for (int i = 0; i < 4; ++i) {
        const int pos = n - 3 + i;
        const int col0 = part * 512 + hd * 128 + g * 16;
        uint4 a = make_uint4(0, 0, 0, 0), b = a;
        if (n < ci.valid) {
          if (pos >= 0 || (!ci.sample && ci.cl > 0)) {
            const uint4* sp = (const uint4*)(PGDN + (size_t)(ci.tok0 + pos) * 1536 + col0);
            a = sp[0]; b = sp[1];
          } else if (ci.sample) {
            const float* cb = p.state_conv + ((size_t)ci.seq * 3 + (3 + pos)) * 1536 + col0;
            a.x = pk2(cb[0], cb[1]); a.y = pk2(cb[2], cb[3]); a.z = pk2(cb[4], cb[5]); a.w = pk2(cb[6], cb[7]);
            b.x = pk2(cb[8], cb[9]); b.y = pk2(cb[10], cb[11]); b.z = pk2(cb[12], cb[13]); b.w = pk2(cb[14], cb[15]);
          }
        }
        raw[part][i][0] = a; raw[part][i][1] = b;
      }
    __syncthreads();
#pragma unroll
    for (int part = 0; part < 3; ++part) {
      float v[16];
#pragma unroll
      for (int j = 0; j < 16; ++j) v[j] = 0.f;
#pragma unroll
      for (int i = 0; i < 4; ++i) {
        float sv[16];
        unpack16(raw[part][i][0], raw[part][i][1], sv);
        const float4* cw = (const float4*)(sCW + i * 384 + part * 128 + g * 16);
#pragma unroll
        for (int q4 = 0; q4 < 4; ++q4) {
          const float4 w4 = cw[q4];
          v[4 * q4] += sv[4 * q4] * w4.x; v[4 * q4 + 1] += sv[4 * q4 + 1] * w4.y; v[4 * q4 + 2] += sv[4 * q4 + 2] * w4.z; v[4 * q4 + 3] += sv[4 * q4 + 3] * w4.w;
        }
      }
#pragma unroll
      for (int j = 0; j < 16; ++j) v[j] = v[j] * __builtin_amdgcn_rcpf(1.f + __expf(-v[j]));
      if (part < 2) {
        float ss = 0.f;
#pragma unroll
        for (int j = 0; j < 16; ++j) ss += v[j] * v[j];
        ss += __shfl_xor(ss, 1); ss += __shfl_xor(ss, 2); ss += __shfl_xor(ss, 4);
        const float sc = rsqrtf(ss + 1e-6f) * (part == 0 ? 0.08838834764831845f : 1.f);
#pragma unroll
        for (int j = 0; j < 16; ++j) v[j] *= sc;
        u16* dst = (part == 0 ? sQ : sK) + n * LD + g * 16;
        uint4 o0, o1;
        o0.x = pk2(v[0], v[1]); o0.y = pk2(v[2], v[3]); o0.z = pk2(v[4], v[5]); o0.w = pk2(v[6], v[7]);
        o1.x = pk2(v[8], v[9]); o1.y = pk2(v[10], v[11]); o1.z = pk2(v[12], v[13]); o1.w = pk2(v[14], v[15]);
        *(uint4*)dst = o0; *(uint4*)(dst + 8) = o1;
      }
      if (part == 1) {
        const float sb = sBe[n] * sEg[n], sk = sEk[n];
#pragma unroll
        for (int j = 0; j < 16; ++j) {
          const float kr = bf2f(f2bf(v[j]));
          sKbT[(g * 16 + j) * LT + n] = f2bf(kr * sb);
          sKtT[(g * 16 + j) * LT + n] = f2bf(kr * sk);
        }
      } else if (part == 2) {
        const float sb = sBe[n];
#pragma unroll
        for (int j = 0; j < 16; ++j) sVbT[(g * 16 + j) * LT + n] = f2bf(bf2f(f2bf(v[j])) * sb);
      }
    }
  }
  __syncthreads();
  {
    const int which = wid >> 2, ti = (wid >> 1) & 1, tj = wid & 1;
    f32x16 acc;
#pragma unroll
    for (int i = 0; i < 16; ++i) acc[i] = 0.f;
    mma_tile_vec<8>(acc, (which ? sQ : sK) + 32 * ti * LD, LD, sK + 32 * tj * LD, LD, r, h);
#pragma unroll
    for (int i = 0; i < 16; ++i) {
      const int n = 32 * ti + crow(i, h), m = 32 * tj + r;
      const float d = __expf(fminf(sG[n] - sG[m], 0.f));
      if (which == 0) sL[n * 68 + m] = (m < n) ? sBe[n] * acc[i] * d : 0.f;
      else sQK[n * LT + m] = (m <= n) ? f2bf(acc[i] * d) : (u16)0;
    }
  }
  __syncthreads();
  if (wid == 0) {
    const int hb = lane >> 5, cl = lane & 31;
    float x[32];
#pragma unroll
    for (int i = 0; i < 32; ++i) x[i] = 0.f;
    const float* sLr = sL + (32 * hb) * 68 + 32 * hb;
    asm volatile("" : "+v"(sLr));
#pragma unroll
    for (int i = 0; i < 32; ++i) {
      float a0 = fmaxf(1.f - fabsf((float)(cl - i)), 0.f), a1 = 0.f, a2 = 0.f, a3 = 0.f;
#pragma unroll
      for (int jj = 0; jj * 4 < i; ++jj) {
        const float4 l = *(const float4*)(sLr + i * 68 + jj * 4);
        a0 -= l.x * x[4 * jj]; a1 -= l.y * x[4 * jj + 1]; a2 -= l.z * x[4 * jj + 2]; a3 -= l.w * x[4 * jj + 3];
      }
      const float a = (a0 + a1) + (a2 + a3);
      x[i] = a;
      sT[(32 * hb + i) * LT + 32 * hb + cl] = f2bf(a);
      if (hb == 0) { sT[i * LT + 32 + cl] = 0; sTT[cl * LT + i] = f2bf(a); }
    }
    f32x16 P;
#pragma unroll
    for (int i = 0; i < 16; ++i) P[i] = 0.f;
#pragma unroll
    for (int s2 = 0; s2 < 2; ++s2) {
      const float4 l0 = *(const float4*)(sL + (32 + r) * 68 + 16 * s2 + 8 * h), l1 = *(const float4*)(sL + (32 + r) * 68 + 16 * s2 + 8 * h + 4);
      u32x4 aw; aw.x = pk2(l0.x, l0.y); aw.y = pk2(l0.z, l0.w); aw.z = pk2(l1.x, l1.y); aw.w = pk2(l1.z, l1.w);
      const bf16x8 a = __builtin_bit_cast(bf16x8, aw);
      const bf16x8 b = *(const bf16x8*)(sTT + r * LT + 16 * s2 + 8 * h);
      P = MFMA(a, b, P);
    }
    f32x16 Q;
#pragma unroll
    for (int i = 0; i < 16; ++i) Q[i] = 0.f;
#pragma unroll
    for (int s2 = 0; s2 < 2; ++s2) {
      const uint2 t0 = *(const uint2*)(sT + (32 + r) * LT + 32 + 16 * s2 + 4 * h), t1 = *(const uint2*)(sT + (32 + r) * LT + 32 + 16 * s2 + 8 + 4 * h);
      u32x4 aw; aw.x = t0.x; aw.y = t0.y; aw.z = t1.x; aw.w = t1.y;
      Q = MFMA(__builtin_bit_cast(bf16x8, aw), pack8(P, s2), Q);
    }
#pragma unroll
    for (int i = 0; i < 16; ++i) sT[(32 + crow(i, h)) * LT + r] = f2bf(-Q[i]);
  } else {
    const int r0 = ch * 16 + (wid - 1);
    float4 tv[3][4];
#pragma unroll
    for (int k = 0; k < 3; ++k) {
      const int row = r0 + 7 * k;
      if (row < ch * 16 + 16 && row < 32768) {
        const float* src = (row < 16384 ? p.peer_u + (size_t)row * 1024 : p.peer_v + (size_t)(row - 16384) * 1024) + lane * 16;
#pragma unroll
        for (int q = 0; q < 4; ++q) tv[k][q] = ((const float4*)src)[q];
      }
    }
#pragma unroll
    for (int k = 0; k < 3; ++k) {
      const int row = r0 + 7 * k;
      if (row < ch * 16 + 16 && row < 32768) {
        float am = 0.f;
#pragma unroll
        for (int q = 0; q < 4; ++q) am = fmaxf(am, fmaxf(fmaxf(fabsf(tv[k][q].x), fabsf(tv[k][q].y)), fmaxf(fabsf(tv[k][q].z), fabsf(tv[k][q].w))));
#pragma unroll
        for (int o = 32; o > 0; o >>= 1) am = fmaxf(am, __shfl_xor(am, o));
        const float sc = am > 0.f ? 256.f / am : 1.f;
        unsigned w4[4];
#pragma unroll
        for (int q = 0; q < 4; ++q) {
          int t = 0;
          t = __builtin_amdgcn_cvt_pk_fp8_f32(tv[k][q].x * sc, tv[k][q].y * sc, t, false);
          t = __builtin_amdgcn_cvt_pk_fp8_f32(tv[k][q].z * sc, tv[k][q].w * sc, t, true);
          w4[q] = (unsigned)t;
        }
        unsigned char* dstb = (unsigned char*)(ws + (row < 16384 ? OFF_UB : OFF_VB)) + (size_t)(row & 16383) * 1024 + lane * 16;
        *(uint4*)dstb = make_uint4(w4[0], w4[1], w4[2], w4[3]);
        if (lane == 0) ((float*)(ws + (row < 16384 ? OFF_USC : OFF_VSC)))[row & 16383] = am > 0.f ? am * (1.f / 256.f) : 1.f;
      }
    }
  }
  __syncthreads();
  {
    f32x16 acc2[2];
#pragma unroll
    for (int z = 0; z < 2; ++z) {
      const int q = wid * 2 + z, which = q >> 3, ti = (q >> 2) & 1, tj = q & 3;
#pragma unroll
      for (int i = 0; i < 16; ++i) acc2[z][i] = 0.f;
      mma_tile_vec<4>(acc2[z], sT + 32 * ti * LT, LT, (which ? sVbT : sKbT) + 32 * tj * LT, LT, r, h);
    }
    __syncthreads();
#pragma unroll
    for (int z = 0; z < 2; ++z) {
      const int q = wid * 2 + z, which = q >> 3, ti = (q >> 2) & 1, tj = q & 3;
      const float sg = which ? 1.f : -1.f;
      u16* dst = (which ? sUT : sWT) + (32 * tj + r) * LT + 32 * ti + 4 * h;
#pragma unroll
      for (int g = 0; g < 4; ++g) {
        uint2 o;
        o.x = pk2(sg * acc2[z][4 * g], sg * acc2[z][4 * g + 1]);
        o.y = pk2(sg * acc2[z][4 * g + 2], sg * acc2[z][4 * g + 3]);
        *(uint2*)(dst + 8 * g) = o;
      }
    }
  }
  __syncthreads();
  char* gi = ws + OFF_GI + (size_t)ch * 98304;
#pragma unroll 1
  for (int q = wid; q < 48; q += 8) {
    f32x16 acc;
#pragma unroll
    for (int i = 0; i < 16; ++i) acc[i] = 0.f;
    if (q < 16) {
      const int t_in = q >> 2, t_out = q & 3;
      mma_tile_vec<4>(acc, sWT + 32 * t_in * LT, LT, sKtT + 32 * t_out * LT, LT, r, h);
#pragma unroll
      for (int s2 = 0; s2 < 2; ++s2) *(bf16x8*)(gi + ((size_t)((t_out * 8 + 2 * t_in + s2) * 64 + lane)) * 16) = pack8(acc, s2);
    } else if (q < 32) {
      const int t = (q - 16) >> 2, we = (q - 16) & 3;
      mma_tile_vec<4>(acc, sKtT + 32 * t * LT, LT, sUT + 32 * we * LT, LT, r, h);
      char* dst = gi + 32768 + ((size_t)((we * 4 + t) * 64 + lane)) * 32;
      *(bf16x8*)dst = pack8(acc, 0); *(bf16x8*)(dst + 16) = pack8(acc, 1);
    } else if (q < 40) {
      const int td = (q - 32) >> 1, tn = (q - 32) & 1;
      const float eg = sEg[32 * tn + r];
#pragma unroll
      for (int g = 0; g < 4; ++g) {
        const uint2 qv = *(const uint2*)(sQ + (32 * tn + r) * LD + 32 * td + 8 * g + 4 * h);
        acc[4 * g] = bflo(qv.x) * eg; acc[4 * g + 1] = bfhi(qv.x) * eg; acc[4 * g + 2] = bflo(qv.y) * eg; acc[4 * g + 3] = bfhi(qv.y) * eg;
      }
      mma_tile_vec<4>(acc, sWT + 32 * td * LT, LT, sQK + 32 * tn * LT, LT, r, h);
#pragma unroll
      for (int s2 = 0; s2 < 2; ++s2) *(bf16x8*)(gi + 65536 + ((size_t)((tn * 8 + 2 * td + s2) * 64 + lane)) * 16) = pack8(acc, s2);
    } else {
      const int tn = (q - 40) >> 2, we = (q - 40) & 3;
      mma_tile_vec<4>(acc, sQK + 32 * tn * LT, LT, sUT + 32 * we * LT, LT, r, h);
      char* dst = gi + 81920 + ((size_t)((we * 2 + tn) * 64 + lane)) * 32;
      *(bf16x8*)dst = pack8(acc, 0); *(bf16x8*)(dst + 16) = pack8(acc, 1);
    }
  }
  __syncthreads();
}

struct GlaLds { u16 *sQ, *sK, *sV; float *sG, *sX; };
DI GlaLds gla_carve(char* smem) {
  GlaLds L;
  L.sQ = (u16*)smem; L.sK = L.sQ + 64 * 72; L.sV = L.sK + 64 * 72;
  L.sG = (float*)(L.sV + 64 * 136); L.sX = L.sG + 64 * 65;
  return L;
}
DI void gla_load(const Params& p, int c, int hd, const GlaLds& L) {
  int tid = threadIdx.x;
  asm volatile("" : "+v"(tid));
  char* ws = p.ws;
  float* outp = p.out;
  asm volatile("" : "+s"(ws), "+s"(outp));
  const ChunkInfo ci = chunk_info(c);
  const u16* PG = (const u16*)(ws + OFF_PGLA);
  const float* PSM = outp + OOFF_PSMALL;
  {
    const int n = tid >> 3, g = tid & 7;
    uint4 q4 = make_uint4(0, 0, 0, 0), k4 = q4, v0 = q4, v1 = q4;
    if (n < ci.valid) {
      const u16* rowp = PG + (size_t)(ci.tok0 + n) * 1024;
      q4 = *(const uint4*)(rowp + hd * 64 + g * 8);
      k4 = *(const uint4*)(rowp + 256 + hd * 64 + g * 8);
      v0 = *(const uint4*)(rowp + 512 + hd * 128 + g * 16);
      v1 = *(const uint4*)(rowp + 512 + hd * 128 + g * 16 + 8);
      q4.x = pk2(bflo(q4.x) * 0.125f, bfhi(q4.x) * 0.125f); q4.y = pk2(bflo(q4.y) * 0.125f, bfhi(q4.y) * 0.125f);
      q4.z = pk2(bflo(q4.z) * 0.125f, bfhi(q4.z) * 0.125f); q4.w = pk2(bflo(q4.w) * 0.125f, bfhi(q4.w) * 0.125f);
    }
    *(uint4*)(L.sQ + n * 72 + g * 8) = q4;
    *(uint4*)(L.sK + n * 72 + g * 8) = k4;
    *(uint4*)(L.sV + n * 136 + g * 16) = v0;
    *(uint4*)(L.sV + n * 136 + g * 16 + 8) = v1;
  }
  for (int e = tid; e < 64 * 16; e += NTHR) {
    const int n = e >> 4, rr = e & 15;
    L.sX[e] = (n < ci.valid) ? PSM[(size_t)(ci.tok0 + n) * 32 + rr] : 0.f;
  }
  __syncthreads();
  {
    const int d = tid & 63, n0 = (tid >> 6) * 8;
    float wk[16];
#pragma unroll
    for (int rr = 0; rr < 16; ++rr) wk[rr] = p.gla_w_gk2[rr * 256 + hd * 64 + d];
    const float bias = p.gla_b_gk[hd * 64 + d];
    float run = 0.f, la[8];
#pragma unroll
    for (int i = 0; i < 8; ++i) {
      const int n = n0 + i;
      float z = bias;
#pragma unroll
      for (int rr = 0; rr < 16; ++rr) z += L.sX[n * 16 + rr] * wk[rr];
      float ls = fminf(z, 0.f) - __logf(1.f + __expf(-fabsf(z)));
      ls = (n < ci.valid) ? ls * (1.f / 16.f) : 0.f;
      run += ls; la[i] = run;
    }
    float* part = L.sX + 1024;
    part[(tid >> 6) * 64 + d] = run;
    __syncthreads();
    float pre = 0.f;
    for (int b = 0; b < (tid >> 6); ++b) pre += part[b * 64 + d];
#pragma unroll
    for (int i = 0; i < 8; ++i) L.sG[(n0 + i) * 65 + d] = la[i] + pre;
  }
  __syncthreads();
}

DI void gla_prep(const Params& p, int c, int hd, char* smem) {
  const GlaLds L = gla_carve(smem);
  int tid = threadIdx.x;
  asm volatile("" : "+v"(tid));
  char* ws = p.ws;
  float* outp = p.out;
  asm volatile("" : "+s"(ws), "+s"(outp));
  const int lane = tid & 63, wid = tid >> 6, r = lane & 31, h = lane >> 5;
  const int ch = c * 4 + hd;
  gla_load(p, c, hd, L);
  const int td = wid >> 2, te = wid & 3;
  f32x16 acc;
#pragma unroll
  for (int i = 0; i < 16; ++i) acc[i] = 0.f;
  mma_tile<4>(acc, [&](int i, int k) { const int d = 32 * td + i; return f2bf(bf2f(L.sK[k * 72 + d]) * __expf(L.sG[63 * 65 + d] - L.sG[k * 65 + d])); },
              [&](int k, int j) { return L.sV[k * 136 + 32 * te + j]; }, r, h);
  float* GB = outp + OOFF_GB + (size_t)ch * 8192;
#pragma unroll
  for (int i = 0; i < 16; ++i) GB[(32 * td + crow(i, h)) * 128 + 32 * te + r] = acc[i];
  if (tid < 64) (outp + OOFF_GLD)[(size_t)ch * 64 + tid] = __expf(L.sG[63 * 65 + tid]);
  __syncthreads();
}

DI void gla_out(const Params& p, int c, int hd, char* smem) {
  const GlaLds L = gla_carve(smem);
  u16* sS = (u16*)(L.sX + 1024 + 512);
  u16* sAtt = sS + 64 * 136;
  float* sO = (float*)(sAtt + 64 * 72);
  int tid = threadIdx.x;
  asm volatile("" : "+v"(tid));
  char* ws = p.ws;
  float* outp = p.out;
  asm volatile("" : "+s"(ws), "+s"(outp));
  const int lane = tid & 63, wid = tid >> 6, r = lane & 31, h = lane >> 5;
  const int ch = c * 4 + hd;
  const ChunkInfo ci = chunk_info(c);
  gla_load(p, c, hd, L);
  {
    const float* GB = outp + OOFF_GB + (size_t)ch * 8192;
    for (int e = tid; e < 64 * 32; e += NTHR) {
      const int d = e >> 5, q4 = e & 31;
      const float4 v = ((const float4*)GB)[e];
      uint2 o; o.x = pk2(v.x, v.y); o.y = pk2(v.z, v.w);
      *(uint2*)(sS + d * 136 + q4 * 4) = o;
    }
  }
  if (wid < 4) {
    const int ti = wid >> 1, tj = wid & 1;
    if (!(ti == 0 && tj == 1)) {
      f32x16 acc;
#pragma unroll
      for (int i = 0; i < 16; ++i) acc[i] = 0.f;
      mma_tile<4>(acc, [&](int i, int k) { const int n = 32 * ti + i; return f2bf(bf2f(L.sQ[n * 72 + k]) * __expf(L.sG[n * 65 + k] - L.sG[32 * 65 + k])); },
                  [&](int k, int j) { const int m = 32 * tj + j; return f2bf(bf2f(L.sK[m * 72 + k]) * __expf(L.sG[32 * 65 + k] - L.sG[m * 65 + k])); }, r, h);
#pragma unroll
      for (int i = 0; i < 16; ++i) { const int n = 32 * ti + crow(i, h), m = 32 * tj + r; sAtt[n * 72 + m] = (m <= n) ? f2bf(acc[i]) : (u16)0; }
    } else {
#pragma unroll
      for (int i = 0; i < 16; ++i) sAtt[(crow(i, h)) * 72 + 32 + r] = 0;
    }
  }
  __syncthreads();
  {
    const int tn = wid >> 2, te = wid & 3;
    f32x16 acc;
#pragma unroll
    for (int i = 0; i < 16; ++i) acc[i] = 0.f;
    mma_tile<4>(acc, [&](int i, int k) { const int n = 32 * tn + i; return f2bf(bf2f(L.sQ[n * 72 + k]) * __expf(L.sG[n * 65 + k])); },
                [&](int k, int j) { return sS[k * 136 + 32 * te + j]; }, r, h);
    mma_tile<4>(acc, [&](int i, int k) { return sAtt[(32 * tn + i) * 72 + k]; },
                [&](int k, int j) { return L.sV[k * 136 + 32 * te + j]; }, r, h);
#pragma unroll
    for (int i = 0; i < 16; ++i) sO[(32 * tn + crow(i, h)) * 132 + 32 * te + r] = acc[i];
  }
  __syncthreads();
  {
    const int n = tid >> 3, g = tid & 7;
    float v[16], ss = 0.f;
#pragma unroll
    for (int j = 0; j < 16; ++j) { v[j] = sO[n * 132 + g * 16 + j]; ss += v[j] * v[j]; }
    ss += __shfl_xor(ss, 1); ss += __shfl_xor(ss, 2); ss += __shfl_xor(ss, 4);
    const float rs = rsqrtf(ss * (1.f / 128.f) + 1e-6f);
    if (n < ci.valid) {
      const int tok = ci.tok0 + n;
      const u16* gp = (const u16*)(ws + OFF_PGATE) + (size_t)tok * 1024 + hd * 128 + g * 16;
      const uint4 g0 = *(const uint4*)gp, g1 = *(const uint4*)(gp + 8);
      const unsigned gg[8] = {g0.x, g0.y, g0.z, g0.w, g1.x, g1.y, g1.z, g1.w};
      unsigned o[8];
#pragma unroll
      for (int j = 0; j < 8; ++j) {
        const float ga = bflo(gg[j]), gb = bfhi(gg[j]);
        const float a = v[2 * j] * rs * p.gla_norm_w[g * 16 + 2 * j] * (ga * __builtin_amdgcn_rcpf(1.f + __expf(-ga)));
        const float b = v[2 * j + 1] * rs * p.gla_norm_w[g * 16 + 2 * j + 1] * (gb * __builtin_amdgcn_rcpf(1.f + __expf(-gb)));
        o[j] = pk2(a, b);
      }
      u16* op = (u16*)(ws + OFF_O) + (size_t)tok * 1024 + hd * 128 + g * 16;
      *(uint4*)op = make_uint4(o[0], o[1], o[2], o[3]);
      *(uint4*)(op + 8) = make_uint4(o[4], o[5], o[6], o[7]);
    }
  }
  __syncthreads();
}

constexpr int PF = 3;
constexpr int GLA_OUT_EARLY = 1536;
template <int NCHUNKS, int ROLE>
DI void chain_loop(const Params& p, int c0, int sb, int hd, int t, int w, int lane, bf16x8* spbuf) {
  const int r = lane & 31, hh = lane >> 5;
  const bool sample = NCHUNKS == 1;
  const size_t offA = (ROLE == 0 ? (size_t)t * 8192 : 65536 + (size_t)t * 8192) + (size_t)lane * 16;
  const size_t offB = (ROLE == 0 ? 32768 + (size_t)(w * 4 + t) * 2048 : 81920 + (size_t)(w * 2 + t) * 2048) + (size_t)lane * 32;
  f32x16 S;
#pragma unroll
  for (int i = 0; i < 16; ++i)
    S[i] = (sample && ROLE == 0) ? p.state_gdn[((size_t)(sb * 4 + hd) * 128 + 32 * t + crow(i, hh)) * 128 + 32 * w + r] : 0.f;
  const float* GDEC = (const float*)(p.ws + OFF_GDEC);
  u16* O2 = (u16*)(p.ws + OFF_R1);
  bf16x8 ra[PF][8];
  uint4 rb[PF][2];
  float rdec[PF];
#define CH_LOAD(slot, cc)                                                                              \
  if (ROLE != 2) {                                                                                     \
    const int cq_ = (cc) < NCHUNKS ? (cc) : NCHUNKS - 1;                                               \
    const int ch_ = (c0 + cq_) * 4 + hd;                                                               \
    const char* gi_ = p.ws + OFF_GI + (size_t)ch_ * 98304;                                             \
    _Pragma("unroll") for (int ks = 0; ks < 8; ++ks) ra[slot][ks] = *(const bf16x8*)(gi_ + offA + ks * 1024); \
    rb[slot][0] = *(const uint4*)(gi_ + offB); rb[slot][1] = *(const uint4*)(gi_ + offB + 16);        \
    rdec[slot] = GDEC[ch_];                                                                            \
  }
#define CH_STEP(u, c)                                                                                  \
  {                                                                                                    \
    CH_LOAD((u + PF - 1) % PF, (c) + PF - 1);                                                          \
    bf16x8* sp = spbuf + ((c) & 1) * 512;                                                              \
    if (ROLE == 0) { sp[(2 * t) * 64 + lane] = pack8(S, 0); sp[(2 * t + 1) * 64 + lane] = pack8(S, 1); } \
    LDS_BARRIER();                                                                                     \
    if (ROLE != 2) {                                                                                   \
      const unsigned bb[8] = {rb[u][0].x, rb[u][0].y, rb[u][0].z, rb[u][0].w, rb[u][1].x, rb[u][1].y, rb[u][1].z, rb[u][1].w}; \
      const float dec = rdec[u];                                                                       \
      f32x16 acc0;                                                                                     \
      _Pragma("unroll") for (int j = 0; j < 8; ++j) { acc0[2 * j] = S[2 * j] * dec + bflo(bb[j]); acc0[2 * j + 1] = S[2 * j + 1] * dec + bfhi(bb[j]); } \
      _Pragma("unroll") for (int ks = 0; ks < 8; ++ks) acc0 = MFMA(ra[u][ks], sp[ks * 64 + lane], acc0); \
      if (ROLE == 0) {                                                                                 \
        S = acc0;                                                                                      \
      } else {                                                                                         \
        const int tok0_ = sample ? T_P + sb * 32 : (c0 + (c)) * 64;                                    \
        _Pragma("unroll") for (int i = 0; i < 16; ++i) {                                               \
          const int n = 32 * t + crow(i, hh);                                                          \
          if (!sample || n < 32) O2[(size_t)(tok0_ + n) * 512 + hd * 128 + 32 * w + r] = f2bf(acc0[i]); \
        }                                                                                              \
      }                                                                                                \
    }                                                                                                  \
  }
#pragma unroll
  for (int u = 0; u < PF - 1; ++u) { CH_LOAD(u, u); }
  constexpr int NMAIN = (NCHUNKS / PF) * PF;
#pragma unroll 1
  for (int cb = 0; cb < NMAIN; cb += PF) {
    CH_STEP(0, cb);
    CH_STEP(1, cb + 1);
    CH_STEP(2, cb + 2);
  }
  if (NCHUNKS - NMAIN >= 1) CH_STEP(0, NMAIN);
  if (NCHUNKS - NMAIN >= 2) CH_STEP(1, NMAIN + 1);
#undef CH_STEP
#undef CH_LOAD
  if (ROLE == 0) {
    float* dst = p.out + (sample ? OUT_GDN_S : OUT_GDN_P) + (size_t)(sb * 4 + hd) * 16384;
#pragma unroll
    for (int i = 0; i < 16; ++i) dst[(32 * t + crow(i, hh)) * 128 + 32 * w + r] = S[i];
  }
}

template <int NCHUNKS>
DI void gdn_chain2(const Params& p, int chain, int w, char* smem) {
  int tid = threadIdx.x;
  asm volatile("" : "+v"(tid));
  const int lane = tid & 63, wid = __builtin_amdgcn_readfirstlane(tid >> 6);
  bf16x8* spbuf = (bf16x8*)smem;
  int sb, hd, c0;
  if (NCHUNKS != 1) { sb = chain >> 2; hd = chain & 3; c0 = sb * 128; }
  else { sb = (chain - 16) >> 2; hd = (chain - 16) & 3; c0 = 512 + sb; }
  if (wid < 4) chain_loop<NCHUNKS, 0>(p, c0, sb, hd, wid, w, lane, spbuf);
  else if (wid < 6) chain_loop<NCHUNKS, 1>(p, c0, sb, hd, wid - 4, w, lane, spbuf);
  else chain_loop<NCHUNKS, 2>(p, c0, sb, hd, 0, w, lane, spbuf);
  __syncthreads();
}

DI void phase3(const Params& p, char* smem) {
  const int tid = threadIdx.x;
  const int b = blockIdx.x;
  if (b < 64) {
    const int x = b & 7, j = b >> 3;
    gdn_chain2<128>(p, x * 2 + (j >> 2), j & 3, smem);
#ifdef REP_P3
    gdn_chain2<128>(p, x * 2 + (j >> 2), j & 3, smem);
#endif
    return;
  }
  const int nb = gridDim.x - 64;
  for (int u = b - 64; u < 256; u += nb) gdn_chain2<1>(p, 16 + (u >> 2), u & 3, smem);
  const int gt = (b - 64) * NTHR + tid, gn = nb * NTHR;
  float* GB = p.out + OOFF_GB;
  const float* GLD = p.out + OOFF_GLD;
  for (int e = gt; e < 16 * 2048; e += gn) {
    const int sh = e >> 11, de4 = e & 2047, d = de4 >> 5;
    const int seq = sh >> 2, hd = sh & 3;
    float4 S = make_float4(0.f, 0.f, 0.f, 0.f);
    for (int cl = 0; cl < 128; cl += 8) {
      float4 bn[8];
      float dc[8];
#pragma unroll
      for (int u = 0; u < 8; ++u) {
        const int ch = (seq * 128 + cl + u) * 4 + hd;
        bn[u] = ((const float4*)(GB + (size_t)ch * 8192))[de4];
        dc[u] = GLD[(size_t)ch * 64 + d];
      }
#pragma unroll
      for (int u = 0; u < 8; ++u) {
        const int ch = (seq * 128 + cl + u) * 4 + hd;
        ((float4*)(GB + (size_t)ch * 8192))[de4] = S;
        S.x = dc[u] * S.x + bn[u].x; S.y = dc[u] * S.y + bn[u].y; S.z = dc[u] * S.z + bn[u].z; S.w = dc[u] * S.w + bn[u].w;
      }
    }
    ((float4*)(p.out + OUT_GLA_P + (size_t)sh * 8192))[de4] = S;
  }
  for (int e = gt; e < 64 * 2048; e += gn) {
    const int sh = e >> 11, de4 = e & 2047, d = de4 >> 5;
    const int sb = sh >> 2, hd = sh & 3;
    const int ch = (512 + sb) * 4 + hd;
    const float4 S0 = ((const float4*)(p.state_gla + (size_t)sh * 8192))[de4];
    const float4 bnew = ((const float4*)(GB + (size_t)ch * 8192))[de4];
    const float dec = GLD[(size_t)ch * 64 + d];
    ((float4*)(GB + (size_t)ch * 8192))[de4] = S0;
    ((float4*)(p.out + OUT_GLA_S + (size_t)sh * 8192))[de4] = make_float4(dec * S0.x + bnew.x, dec * S0.y + bnew.y, dec * S0.z + bnew.z, dec * S0.w + bnew.w);
  }
  {
    unsigned* ctr = (unsigned*)(p.ws + OFF_BAR);
    asm volatile("s_waitcnt vmcnt(0)" ::: "memory");
    __syncthreads();
    if (tid == 0) {
      __builtin_amdgcn_fence(__ATOMIC_RELEASE, "agent");
      asm volatile("s_waitcnt vmcnt(0)" ::: "memory");
      __hip_atomic_fetch_add(ctr, 1u, __ATOMIC_RELAXED, __HIP_MEMORY_SCOPE_AGENT);
      unsigned sp = 0;
      while (__hip_atomic_load(ctr, __ATOMIC_RELAXED, __HIP_MEMORY_SCOPE_AGENT) < (unsigned)nb) { __builtin_amdgcn_s_sleep(2); if (++sp > (1u << 22)) break; }
      __builtin_amdgcn_fence(__ATOMIC_ACQUIRE, "agent");
      asm volatile("s_waitcnt vmcnt(0)" ::: "memory");
    }
    __syncthreads();
  }
  for (int u = b - 64; u < GLA_OUT_EARLY; u += nb) gla_out(p, u >> 2, u & 3, smem);
}

DI void phase4_misc(const Params& p) {
  const int tid = threadIdx.x, lane = tid & 63;
  for (int i = blockIdx.x * NTHR + tid; i < T_ALL; i += gridDim.x * NTHR) ((float*)(p.ws + OFF_RSS))[i] = 0.f;
  const int gw = blockIdx.x * (NTHR / 64) + (tid >> 6), nw = gridDim.x * (NTHR / 64);
  const u16* O2 = (const u16*)(p.ws + OFF_R1);
  const u16* PGATE = (const u16*)(p.ws + OFF_PGATE);
  u16* O = (u16*)(p.ws + OFF_O);
  for (int tok = gw; tok < T_ALL; tok += nw) {
    const uint4 ov = *(const uint4*)(O2 + (size_t)tok * 512 + lane * 8);
    const uint4 zv = *(const uint4*)(PGATE + (size_t)tok * 1024 + 512 + lane * 8);
    const unsigned oo[4] = {ov.x, ov.y, ov.z, ov.w}, zz[4] = {zv.x, zv.y, zv.z, zv.w};
    float v[8], ss = 0.f;
#pragma unroll
    for (int j = 0; j < 4; ++j) { v[2 * j] = bflo(oo[j]); v[2 * j + 1] = bfhi(oo[j]); ss += v[2 * j] * v[2 * j] + v[2 * j + 1] * v[2 * j + 1]; }
    ss += __shfl_xor(ss, 1); ss += __shfl_xor(ss, 2); ss += __shfl_xor(ss, 4); ss += __shfl_xor(ss, 8);
    const float rs = rsqrtf(ss * (1.f / 128.f) + 1e-6f);
    unsigned o[4];
#pragma unroll
    for (int j = 0; j < 4; ++j) {
      const float za = bflo(zz[j]), zb = bfhi(zz[j]);
      const int e = (lane & 15) * 8 + 2 * j;
      const float a = v[2 * j] * rs * p.gdn_norm_w[e] * (za * __builtin_amdgcn_rcpf(1.f + __expf(-za)));
      const float b = v[2 * j + 1] * rs * p.gdn_norm_w[e + 1] * (zb * __builtin_amdgcn_rcpf(1.f + __expf(-zb)));
      o[j] = pk2(a, b);
    }
    *(uint4*)(O + (size_t)tok * 1024 + 512 + lane * 8) = make_uint4(o[0], o[1], o[2], o[3]);
  }
}

DI void conv_state_out(const Params& p) {
  const int gtid = blockIdx.x * NTHR + threadIdx.x, gn = gridDim.x * NTHR;
  const u16* PGDN = (const u16*)(p.ws + OFF_PGDN);
  for (int e = gtid; e < 4 * 3 * 1536; e += gn) {
    const int col = e % 1536, j = (e / 1536) % 3, b = e / (3 * 1536);
    p.out[OUT_CONV_P + e] = bf2f(PGDN[(size_t)(b * 8192 + 8189 + j) * 1536 + col]);
  }
  for (int e = gtid; e < 16 * 3 * 1536; e += gn) {
    const int col = e % 1536, j = (e / 1536) % 3, b = e / (3 * 1536);
    p.out[OUT_CONV_S + e] = bf2f(PGDN[(size_t)(T_P + b * 32 + 29 + j) * 1536 + col]);
  }
}

DI unsigned dpp_max_row(unsigned v) {
  v = max(v, (unsigned)__builtin_amdgcn_update_dpp(0, (int)v, 0xB1, 0xF, 0xF, false));
  v = max(v, (unsigned)__builtin_amdgcn_update_dpp(0, (int)v, 0x4E, 0xF, 0xF, false));
  v = max(v, (unsigned)__builtin_amdgcn_update_dpp(0, (int)v, 0x141, 0xF, 0xF, false));
  v = max(v, (unsigned)__builtin_amdgcn_update_dpp(0, (int)v, 0x140, 0xF, 0xF, false));
  return v;
}
DI float dpp_sum_row(float v) {
  v += __builtin_bit_cast(float, __builtin_amdgcn_update_dpp(0, __builtin_bit_cast(int, v), 0xB1, 0xF, 0xF, false));
  v += __builtin_bit_cast(float, __builtin_amdgcn_update_dpp(0, __builtin_bit_cast(int, v), 0x4E, 0xF, 0xF, false));
  v += __builtin_bit_cast(float, __builtin_amdgcn_update_dpp(0, __builtin_bit_cast(int, v), 0x141, 0xF, 0xF, false));
  v += __builtin_bit_cast(float, __builtin_amdgcn_update_dpp(0, __builtin_bit_cast(int, v), 0x140, 0xF, 0xF, false));
  return v;
}
DI unsigned mkkey(float f, int c) { unsigned u = __float_as_uint(f); u = (u >> 31) ? ~u : (u | 0x80000000u); return (u & 0xFFFFFF00u) | (unsigned)(255 - c); }
DI float keyval(unsigned k) { const unsigned u = k & 0xFFFFFF00u; return __uint_as_float((u >> 31) ? (u & 0x7FFFFFFFu) : ~u); }
DI int keyidx(unsigned k) { return 255 - (int)(k & 255u); }
DI void ce_desc(unsigned& a, unsigned& b) { const unsigned hi = max(a, b), lo = min(a, b); a = hi; b = lo; }
DI void sort8_desc(unsigned (&k)[8]) {
  ce_desc(k[0], k[1]); ce_desc(k[2], k[3]); ce_desc(k[4], k[5]); ce_desc(k[6], k[7]);
  ce_desc(k[0], k[2]); ce_desc(k[1], k[3]); ce_desc(k[4], k[6]); ce_desc(k[5], k[7]);
  ce_desc(k[1], k[2]); ce_desc(k[5], k[6]);
  ce_desc(k[0], k[4]); ce_desc(k[1], k[5]); ce_desc(k[2], k[6]); ce_desc(k[3], k[7]);
  ce_desc(k[2], k[4]); ce_desc(k[3], k[5]);
  ce_desc(k[1], k[2]); ce_desc(k[3], k[4]); ce_desc(k[5], k[6]);
}
DI unsigned top16_sorted8(unsigned (&k)[8], int l16) {
  unsigned res = 0;
  for (int rnd = 0; rnd < 16; ++rnd) {
    const unsigned m = dpp_max_row(k[0]);
    if (l16 == rnd) res = m;
    const bool win = (k[0] == m);
#pragma unroll
    for (int s = 0; s < 7; ++s) k[s] = win ? k[s + 1] : k[s];
    k[7] = win ? 0u : k[7];
  }
  return res;
}

DI void pop_round(unsigned (&k)[8], unsigned& res, int l16, int rnd) {
  const unsigned m = dpp_max_row(k[0]);
  if (l16 == rnd) res = m;
  const bool win = (k[0] == m);
#pragma unroll
  for (int s = 0; s < 7; ++s) k[s] = win ? k[s + 1] : k[s];
  k[7] = win ? 0u : k[7];
}

DI void peer_select(const Params& p, int tile, int hd, char* smem, bool load_keys) {
  u16* sK1 = (u16*)smem;
  u16* sK2 = sK1 + 128 * 136;
  u16* sQ = sK2 + 128 * 136;
  float* sS = (float*)(sQ + 64 * 264);
  int tid = threadIdx.x;
  asm volatile("" : "+v"(tid));
  char* ws = p.ws;
  float* outp = p.out;
  asm volatile("" : "+s"(ws), "+s"(outp));
  const int lane = tid & 63, wid = tid >> 6, r = lane & 31, h = lane >> 5;
  const u16* QP = (const u16*)(ws + OFF_QP);
  const u16* K12 = (const u16*)(ws + OFF_K12);
  const int tok0 = tile * 64;
  for (int e = tid; e < 64 * 32; e += NTHR) {
    const int n = e >> 5, g = e & 31;
    *(uint4*)(sQ + n * 264 + g * 8) = *(const uint4*)(QP + (size_t)(tok0 + n) * 2048 + hd * 256 + g * 8);
  }
  if (load_keys) {
    for (int e = tid; e < 2 * 128 * 16; e += NTHR) {
      const int which = e >> 11, n = (e >> 4) & 127, g = e & 15;
      *(uint4*)(sK1 + which * 128 * 136 + n * 136 + g * 8) = *(const uint4*)(K12 + ((size_t)(which * 8 + hd) * 128 + n) * 128 + g * 8);
    }
  }
  __syncthreads();
  const int l16 = lane & 15, rowb = lane & 48;
  const int tl0 = wid * 8 + (lane >> 4), tl1 = tl0 + 4;
  unsigned ka[8], kb[8], kc[8], kd[8];
  {
    const int tt = wid >> 2, tk = wid & 3;
    f32x16 acc1, acc2;
#pragma unroll
    for (int i = 0; i < 16; ++i) { acc1[i] = 0.f; acc2[i] = 0.f; }
    mma_tile_vec<8>(acc1, sQ + (32 * tt) * 264, 264, sK1 + (32 * tk) * 136, 136, r, h);
    mma_tile_vec<8>(acc2, sQ + (32 * tt) * 264 + 128, 264, sK2 + (32 * tk) * 136, 136, r, h);
#pragma unroll
    for (int i = 0; i < 16; ++i) sS[(32 * tt + crow(i, h)) * 132 + 32 * tk + r] = acc1[i];
    __syncthreads();
#pragma unroll
    for (int s = 0; s < 8; ++s) { const int cc = s * 16 + l16; ka[s] = mkkey(sS[tl0 * 132 + cc], cc); kc[s] = mkkey(sS[tl1 * 132 + cc], cc); }
    __syncthreads();
#pragma unroll
    for (int i = 0; i < 16; ++i) sS[(32 * tt + crow(i, h)) * 132 + 32 * tk + r] = acc2[i];
    __syncthreads();
#pragma unroll
    for (int s = 0; s < 8; ++s) { const int cc = s * 16 + l16; kb[s] = mkkey(sS[tl0 * 132 + cc], cc); kd[s] = mkkey(sS[tl1 * 132 + cc], cc); }
  }
  int* EIDX = (int*)(ws + OFF_EIDX);
  float* GATE = (float*)(ws + OFF_GATE);
  {
    sort8_desc(ka); sort8_desc(kb); sort8_desc(kc); sort8_desc(kd);
    unsigned ra = 0, rb = 0, rc = 0, rd = 0;
    for (int rnd = 0; rnd < 16; ++rnd) {
      pop_round(ka, ra, l16, rnd); pop_round(kb, rb, l16, rnd); pop_round(kc, rc, l16, rnd); pop_round(kd, rd, l16, rnd);
    }
    const float v1[2] = {keyval(ra), keyval(rc)}, v2[2] = {keyval(rb), keyval(rd)};
    const int i1[2] = {keyidx(ra), keyidx(rc)}, i2[2] = {keyidx(rb), keyidx(rd)};
    int ptr[2] = {0, 0};
    unsigned hk[2], r3[2] = {0u, 0u};
#pragma unroll
    for (int gq = 0; gq < 2; ++gq) hk[gq] = mkkey(__shfl(v1[gq], rowb) + v2[gq], l16);
    for (int rnd = 0; rnd < 16; ++rnd) {
#pragma unroll
      for (int gq = 0; gq < 2; ++gq) {
        const unsigned m = dpp_max_row(hk[gq]);
        if (l16 == rnd) r3[gq] = m;
        ptr[gq] += (hk[gq] == m) ? 1 : 0;
        const float va = __shfl(v1[gq], rowb + (ptr[gq] & 15));
        hk[gq] = (ptr[gq] < 16) ? mkkey(va + v2[gq], ptr[gq] * 16 + l16) : 0u;
      }
    }
#pragma unroll
    for (int gq = 0; gq < 2; ++gq) {
      const int cc = keyidx(r3[gq]);
      const float sc = keyval(r3[gq]);
      const int ia = __shfl(i1[gq], rowb + (cc >> 4)), ib = __shfl(i2[gq], rowb + (cc & 15));
      const float mx = __shfl(sc, rowb);
      const float ex = __expf(sc - mx);
      const float sum = dpp_sum_row(ex);
      const size_t o = ((size_t)(tok0 + (gq ? tl1 : tl0)) * 8 + hd) * 16 + l16;
      EIDX[o] = ia * 128 + ib;
      GATE[o] = ex / sum;
    }
  }
  __syncthreads();
}

DI void unpack_fp8x16(const uint4& a, f32x2* f) {
  f[0] = __builtin_amdgcn_cvt_pk_f32_fp8((int)a.x, false); f[1] = __builtin_amdgcn_cvt_pk_f32_fp8((int)a.x, true);
  f[2] = __builtin_amdgcn_cvt_pk_f32_fp8((int)a.y, false); f[3] = __builtin_amdgcn_cvt_pk_f32_fp8((int)a.y, true);
  f[4] = __builtin_amdgcn_cvt_pk_f32_fp8((int)a.z, false); f[5] = __builtin_amdgcn_cvt_pk_f32_fp8((int)a.z, true);
  f[6] = __builtin_amdgcn_cvt_pk_f32_fp8((int)a.w, false); f[7] = __builtin_amdgcn_cvt_pk_f32_fp8((int)a.w, true);
}
DI float wave_sum_dpp(float v) {
  v = dpp_sum_row(v);
  const int b = __builtin_bit_cast(int, v);
  return __builtin_bit_cast(float, __builtin_amdgcn_readlane(b, 0)) + __builtin_bit_cast(float, __builtin_amdgcn_readlane(b, 16)) +
         __builtin_bit_cast(float, __builtin_amdgcn_readlane(b, 32)) + __builtin_bit_cast(float, __builtin_amdgcn_readlane(b, 48));
}
constexpr int GB8 = 16;
DI void phase8(const Params& p) {
  const int tid = threadIdx.x, lane = tid & 63;
  const int gw = blockIdx.x * (NTHR / 64) + (tid >> 6), nw = gridDim.x * (NTHR / 64);
  const u16* H2 = (const u16*)(p.ws + OFF_H2);
  const unsigned char* UB = (const unsigned char*)(p.ws + OFF_UB);
  const unsigned char* VB = (const unsigned char*)(p.ws + OFF_VB);
  const float* USC = (const float*)(p.ws + OFF_USC);
  const float* VSC = (const float*)(p.ws + OFF_VSC);
  const int* EIDX = (const int*)(p.ws + OFF_EIDX);
  const float* GATE = (const float*)(p.ws + OFF_GATE);
  for (int tok = gw; tok < T_ALL; tok += nw) {
    f32x2 hx[8];
    {
      float t[16];
      const uint4* hp = (const uint4*)(H2 + (size_t)tok * 1024 + lane * 16);
      unpack16(hp[0], hp[1], t);
      const float rsn = rsqrtf(((const float*)(p.ws + OFF_RSS))[tok] * (1.f / 1024.f) + 1e-6f);
#pragma unroll
      for (int j = 0; j < 8; ++j) { hx[j].x = t[2 * j] * rsn; hx[j].y = t[2 * j + 1] * rsn; }
    }
    const int e0 = EIDX[(size_t)tok * 128 + lane], e1 = EIDX[(size_t)tok * 128 + 64 + lane];
    const int g0 = __builtin_bit_cast(int, GATE[(size_t)tok * 128 + lane]), g1 = __builtin_bit_cast(int, GATE[(size_t)tok * 128 + 64 + lane]);
    f32x2 acc[8];
#pragma unroll
    for (int j = 0; j < 8; ++j) { acc[j].x = 0.f; acc[j].y = 0.f; }
    for (int rp = 0; rp < REP_P8; ++rp) {
#pragma unroll
    for (int j = 0; j < 8; ++j) { acc[j].x = 0.f; acc[j].y = 0.f; }
    for (int j0 = 0; j0 < 128; j0 += GB8) {
      const int ee = (j0 < 64) ? e0 : e1, gg = (j0 < 64) ? g0 : g1;
      uint4 uq[GB8], vq[GB8];
      float gt[GB8], us[GB8];
#pragma unroll
      for (int u = 0; u < GB8; ++u) {
        const int e = __builtin_amdgcn_readlane(ee, (j0 & 63) + u);
        const float g = __builtin_bit_cast(float, __builtin_amdgcn_readlane(gg, (j0 & 63) + u));
        uq[u] = *(const uint4*)(UB + (size_t)e * 1024 + lane * 16);
        vq[u] = *(const uint4*)(VB + (size_t)e * 1024 + lane * 16);
        gt[u] = g * VSC[e];
        us[u] = USC[e];
      }
#pragma unroll
      for (int u = 0; u < GB8; ++u) {
        f32x2 f[8];
        unpack_fp8x16(uq[u], f);
        f32x2 d2 = f[0] * hx[0];
#pragma unroll
        for (int j = 1; j < 8; ++j) d2 += f[j] * hx[j];
        float d = wave_sum_dpp(d2.x + d2.y) * us[u];
        const float z = 1.5957691216057308f * (d + 0.044715f * d * d * d);
        const float act = d * __builtin_amdgcn_rcpf(1.f + __expf(-z));
        const float wgt = gt[u] * act;
        unpack_fp8x16(vq[u], f);
#pragma unroll
        for (int j = 0; j < 8; ++j) acc[j] += f[j] * wgt;
      }
    }
    }
    float* yr = p.out + OUT_Y + (size_t)tok * 1024 + lane * 16;
    float y[16], ss = 0.f;
#pragma unroll
    for (int q = 0; q < 4; ++q) {
      const float4 xv = ((const float4*)yr)[q];
      y[4 * q] = xv.x + acc[2 * q].x; y[4 * q + 1] = xv.y + acc[2 * q].y; y[4 * q + 2] = xv.z + acc[2 * q + 1].x; y[4 * q + 3] = xv.w + acc[2 * q + 1].y;
    }
#pragma unroll
    for (int j = 0; j < 16; ++j) ss += y[j] * y[j];
    ss = wave_sum(ss);
    const float rs = rsqrtf(ss * (1.f / 1024.f) + 1e-6f);
#pragma unroll
    for (int q = 0; q < 4; ++q) {
      const float4 ww = ((const float4*)(p.norm_final_w + lane * 16))[q];
      float4 o;
      o.x = y[4 * q] * rs * ww.x; o.y = y[4 * q + 1] * rs * ww.y; o.z = y[4 * q + 2] * rs * ww.z; o.w = y[4 * q + 3] * rs * ww.w;
      ((float4*)yr)[q] = o;
    }
  }
}


#define XB_TMO      128
#define XB_XCNT(j)  (256  + 64 * (j))
#define XB_XSUB(j)  (1280 + 64 * (j))
#define XB_XGEN(j)  (2304 + 64 * (j))
#define XB_TOP      3328
#define XB_TOPGEN   3392
#define XCD_BAR_WORDS 3456
#define XB_SPIN_CAP (1u << 18)
#define LAS __attribute__((address_space(3)))
DI unsigned xb_ld(unsigned* p) { return __hip_atomic_load(p, __ATOMIC_RELAXED, __HIP_MEMORY_SCOPE_AGENT); }
DI unsigned xb_add(unsigned* p, unsigned v) { return __hip_atomic_fetch_add(p, v, __ATOMIC_RELAXED, __HIP_MEMORY_SCOPE_AGENT); }
DI unsigned xb_xcc_id() { return (unsigned)__builtin_amdgcn_s_getreg((3 << 11) | 20) & 0xFu; }
#define XB_SPIN(cond, bar) do { unsigned _sp = 0; while (cond) { __builtin_amdgcn_s_sleep(1); \
    if ((++_sp & 255u) == 0u) { if (xb_ld(&(bar)[XB_TMO])) break; if (_sp > XB_SPIN_CAP) { atomicAdd(&(bar)[XB_TMO], 1u); break; } } } } while (0)
struct XcdBarrier { unsigned* bar; unsigned x; volatile LAS unsigned* st; };
DI XcdBarrier xcd_barrier_post(unsigned* bar, volatile LAS unsigned* st) {
  XcdBarrier b; b.bar = bar; b.x = xb_xcc_id(); b.st = st;
  if (threadIdx.x == 0) (void)xb_add(&bar[XB_XCNT(b.x)], 1u);
  return b;
}
DI void xcd_barrier_complete(unsigned* bar, unsigned x, unsigned& nloc, unsigned& nx) {
  const unsigned G = gridDim.x * gridDim.y * gridDim.z;
  unsigned sum, cnt, mine, sp = 0u;
  for (;;) {
    sum = 0u; cnt = 0u; mine = 0u;
#pragma unroll
    for (unsigned j = 0; j < 16; ++j) { const unsigned c = xb_ld(&bar[XB_XCNT(j)]); sum += c; cnt += (c > 0u) ? 1u : 0u; mine = (j == x) ? c : mine; }
    if (sum == G) break;
    __builtin_amdgcn_s_sleep(1);
    if ((++sp & 255u) == 0u) { if (xb_ld(&bar[XB_TMO])) break; if (sp > XB_SPIN_CAP) { atomicAdd(&bar[XB_TMO], 1u); break; } }
  }
  nloc = mine > 0u ? mine : 1u; nx = cnt > 0u ? cnt : 1u;
}
DI void xcd_barrier(const XcdBarrier& b) {
  asm volatile("s_waitcnt vmcnt(0)" ::: "memory");
  __syncthreads();
  if (threadIdx.x == 0) {
    unsigned* bar = b.bar;
    __builtin_amdgcn_s_waitcnt(0);
    unsigned nloc = b.st[0], nx = b.st[1];
    if (nloc == 0u) { xcd_barrier_complete(bar, b.x, nloc, nx); b.st[0] = nloc; b.st[1] = nx; }
    const unsigned old = xb_add(&bar[XB_XSUB(b.x)], 1u);
    const unsigned gen = old / nloc;
    if (old + 1u == (gen + 1u) * nloc) {
      __builtin_amdgcn_fence(__ATOMIC_RELEASE, "agent");
      asm volatile("s_waitcnt vmcnt(0)" ::: "memory");
      const unsigned og = xb_add(&bar[XB_TOP], 1u);
      const unsigned tg = og / nx;
      if (og + 1u == (tg + 1u) * nx) xb_add(&bar[XB_TOPGEN], 1u);
      else XB_SPIN(xb_ld(&bar[XB_TOPGEN]) == tg, bar);
      __builtin_amdgcn_fence(__ATOMIC_ACQUIRE, "agent");
      xb_add(&bar[XB_XGEN(b.x)], 1u);
      asm volatile("s_waitcnt vmcnt(0)" ::: "memory");
    } else {
      XB_SPIN(xb_ld(&bar[XB_XGEN(b.x)]) == gen, bar);
      __builtin_amdgcn_fence(__ATOMIC_ACQUIRE, "agent");
      asm volatile("s_waitcnt vmcnt(0)" ::: "memory");
    }
  }
  __syncthreads();
}

__global__ void __launch_bounds__(NTHR) mega(Params p) {
  extern __shared__ __attribute__((aligned(16))) char smem[];
  cg::grid_group grid = cg::this_grid();
  __shared__ uint4 xb_words;
  if (threadIdx.x == 0) xb_words = make_uint4(0u, 0u, 0u, 0u);
  __syncthreads();
  if (blockIdx.x == 0) for (int i = threadIdx.x; i < XCD_BAR_WORDS; i += NTHR) ((unsigned*)(p.ws + OFF_BAR))[i] = 0u;
  phase0(p);
  grid.sync();
  const XcdBarrier xb = xcd_barrier_post((unsigned*)(p.ws + OFF_BAR), (volatile LAS unsigned*)&xb_words);
#if REP_P0 > 1
  phase0(p);
  xcd_barrier(xb);
#endif
  for (int rp = 0; rp < REP_P1; ++rp) {
    u16* PGLA = (u16*)(p.ws + OFF_PGLA); u16* PGATE = (u16*)(p.ws + OFF_PGATE); u16* PGDN = (u16*)(p.ws + OFF_PGDN);
    float* PSM = p.out + OOFF_PSMALL;
    gemm_phase((const u16*)(p.ws + OFF_R1), (const u16*)(p.ws + OFF_WIN), 3712,
               [&](int row, int col, const f32x16 (&acc)[2][2]) {
                 const int ct = col & ~127;
                 if (ct < 1024) store_tile_bf16<1024>(PGLA + (size_t)row * 1024 + col, acc);
                 else if (ct < 2048) store_tile_bf16<1024>(PGATE + (size_t)row * 1024 + (col - 1024), acc);
                 else if (ct < 3584) store_tile_bf16<1536>(PGDN + (size_t)row * 1536 + (col - 2048), acc);
                 else if (col < 3616) {
#pragma unroll
                   for (int mi = 0; mi < 2; ++mi)
#pragma unroll
                     for (int i = 0; i < 16; ++i) PSM[(size_t)(row + mi * 32 + (i & 3) + 8 * (i >> 2)) * 32 + (col - 3584)] = acc[mi][0][i];
                 }
               }, smem);
    xcd_barrier(xb);
  }
  conv_state_out(p);
  for (int rp = 0; rp < REP_P2L; ++rp) {
    for (int u = blockIdx.x; u < NCH; u += gridDim.x) gla_prep(p, u >> 2, u & 3, smem);
    if (rp + 1 < REP_P2L) xcd_barrier(xb);
  }
  for (int rp = 0; rp < REP_P2G; ++rp) {
    for (int u = gridDim.x - 1 - blockIdx.x; u < NCH; u += gridDim.x) gdn_prep(p, u >> 2, u & 3, smem);
    if (rp + 1 < REP_P2G) xcd_barrier(xb);
  }
  xcd_barrier(xb);
  phase3(p, smem);
  xcd_barrier(xb);
  for (int u = GLA_OUT_EARLY + blockIdx.x; u < NCH; u += gridDim.x) gla_out(p, u >> 2, u & 3, smem);
  for (int rp = 0; rp < REP_P4B; ++rp) {
    phase4_misc(p);
    xcd_barrier(xb);
  }
  for (int rp = 0; rp < REP_P5; ++rp) {
    float* X1 = p.out + OUT_Y;
    u16* H2u = (u16*)(p.ws + OFF_H2);
    float* RSS = (float*)(p.ws + OFF_RSS);
    gemm_phase((const u16*)(p.ws + OFF_O), (const u16*)(p.ws + OFF_WOUT), 1024,
               [&](int row, int col, const f32x16 (&acc)[2][2]) {
                 float* q0 = X1 + (size_t)row * 1024 + col;
                 const float* x0 = xrow(p, row) + col;
                 u16* h0 = H2u + (size_t)row * 1024 + col;
                 const float wf0 = p.norm_ffn_w[col], wf1 = p.norm_ffn_w[col + 32];
                 const int lane_ = threadIdx.x & 63;
#pragma unroll
                 for (int mi = 0; mi < 2; ++mi)
#pragma unroll
                   for (int g = 0; g < 4; ++g)
#pragma unroll
                     for (int j = 0; j < 4; ++j) {
                       size_t off = (size_t)(mi * 32 + 8 * g + j) * 1024;
                       asm volatile("" : "+v"(off));
                       const float v0 = x0[off] + acc[mi][0][4 * g + j], v1 = x0[off + 32] + acc[mi][1][4 * g + j];
                       q0[off] = v0; q0[off + 32] = v1;
                       h0[off] = f2bf(v0 * wf0); h0[off + 32] = f2bf(v1 * wf1);
                       float sq = dpp_sum_row(v0 * v0 + v1 * v1);
                       sq += __shfl_xor(sq, 16);
                       if ((lane_ & 31) == 0) atomicAdd(RSS + row + mi * 32 + 8 * g + j, sq);
                     }
               }, smem);
  xcd_barrier(xb);
  }
  for (int rp = 0; rp < REP_P6; ++rp) {
    u16* QP = (u16*)(p.ws + OFF_QP);
    gemm_phase((const u16*)(p.ws + OFF_H2), (const u16*)(p.ws + OFF_WQ), 2048,
               [&](int row, int col, const f32x16 (&acc)[2][2]) {
                 const float* RSS = (const float*)(p.ws + OFF_RSS);
#pragma unroll
                 for (int mi = 0; mi < 2; ++mi)
#pragma unroll
                   for (int g = 0; g < 4; ++g)
#pragma unroll
                     for (int j = 0; j < 4; ++j) {
                       const int rr = row + mi * 32 + 8 * g + j;
                       const float rs = rsqrtf(RSS[rr] * (1.f / 1024.f) + 1e-6f);
                       u16* q = QP + (size_t)rr * 2048 + col;
                       asm volatile("" : "+v"(q));
                       q[0] = f2bf(acc[mi][0][4 * g + j] * rs);
                       q[32] = f2bf(acc[mi][1][4 * g + j] * rs);
                     }
               }, smem);
  xcd_barrier(xb);
  }
  for (int rp = 0; rp < REP_P7; ++rp) {
    int khd = -1;
    for (int u = blockIdx.x; u < 520 * 8; u += gridDim.x) { peer_select(p, u >> 3, u & 7, smem, (u & 7) != khd); khd = u & 7; }
    xcd_barrier(xb);
  }
#ifdef REP_SYNC
  for (int i = 0; i < REP_SYNC; ++i) xcd_barrier(xb);
#endif
  phase8(p);
}

extern "C" void kernel_launch(void* const* d_in, const int* in_sizes, int n_in, void* d_out, int out_size, void* d_ws,
                              size_t ws_size, hipStream_t stream) {
  static int grid_blocks = 0;
  if (!grid_blocks) {
    int dev = 0, cus = 0, per_cu = 0;
    (void)hipGetDevice(&dev);
    (void)hipDeviceGetAttribute(&cus, hipDeviceAttributeMultiprocessorCount, dev);
    (void)hipFuncSetAttribute((const void*)mega, hipFuncAttributeMaxDynamicSharedMemorySize, (int)LDS_BYTES);
    (void)hipOccupancyMaxActiveBlocksPerMultiprocessor(&per_cu, mega, NTHR, LDS_BYTES);
    if (per_cu < 1) per_cu = 1;
    grid_blocks = cus * per_cu;
    if (ws_size < WS_NEED) fprintf(stderr, "workspace too small: %zu < %zu\n", ws_size, (size_t)WS_NEED);
  }
  Params p{};
  const float** pp = (const float**)&p;
  for (int i = 0; i < 22; ++i) pp[i] = (const float*)d_in[i];
  p.out = (float*)d_out;
  p.ws = (char*)d_ws;
  void* args[] = {&p};
  hipError_t e = hipLaunchCooperativeKernel((void*)mega, dim3(grid_blocks), dim3(NTHR), args, LDS_BYTES, stream);
  if (e != hipSuccess) fprintf(stderr, "cooperative launch failed: %s (grid %d)\n", hipGetErrorString(e), grid_blocks);
}
```

```cpp
#include <hip/hip_runtime.h>
#include <hip/hip_cooperative_groups.h>
#include <cstdio>
#include <cstdint>
namespace cg = cooperative_groups;

#define DI __device__ __forceinline__
typedef unsigned short u16;
typedef short bf16x8 __attribute__((ext_vector_type(8)));
typedef float f32x16 __attribute__((ext_vector_type(16)));
typedef float f32x2 __attribute__((ext_vector_type(2)));
typedef __bf16 bf16x2_t __attribute__((ext_vector_type(2)));
typedef unsigned u32x4 __attribute__((ext_vector_type(4)));

#ifndef REP_P0
#define REP_P0 1
#endif
#ifndef REP_P1
#define REP_P1 1
#endif
#ifndef REP_P2G
#define REP_P2G 1
#endif
#ifndef REP_P2L
#define REP_P2L 1
#endif
#ifndef REP_P3G
#define REP_P3G 1
#endif
#ifndef REP_P4A
#define REP_P4A 1
#endif
#ifndef REP_P4B
#define REP_P4B 1
#endif
#ifndef REP_P5
#define REP_P5 1
#endif
#ifndef REP_P6
#define REP_P6 1
#endif
#ifndef REP_P8
#define REP_P8 1
#endif
#ifndef REP_P7
#define REP_P7 1
#endif
constexpr int NTHR = 512;
constexpr int T_ALL = 33280, T_P = 32768;
constexpr int NCH = 2112;
constexpr size_t LDS_BYTES = 147456;

constexpr size_t OFF_WIN = 0;
constexpr size_t OFF_WOUT = OFF_WIN + 3840ull * 1024 * 2;
constexpr size_t OFF_WQ = OFF_WOUT + 1024ull * 1024 * 2;
constexpr size_t OFF_K12 = OFF_WQ + 2048ull * 1024 * 2;
constexpr size_t OFF_R1 = OFF_K12 + 2ull * 8 * 128 * 128 * 2;
constexpr size_t OFF_R2 = OFF_R1 + (size_t)T_ALL * 1024 * 2;
constexpr size_t OFF_PGLA = OFF_R2;
constexpr size_t OFF_PGATE = OFF_PGLA + (size_t)T_ALL * 1024 * 2;
constexpr size_t OFF_PGDN = OFF_PGATE + (size_t)T_ALL * 1024 * 2;
constexpr size_t OFF_R3 = OFF_PGDN + (size_t)T_ALL * 1536 * 2;
constexpr size_t OFF_GI = OFF_R3;
constexpr size_t OFF_GDEC = OFF_GI + (size_t)NCH * 98304;
constexpr size_t OFF_BAR = (OFF_GDEC + NCH * 4 + 255) / 256 * 256;
constexpr size_t OFF_RSS = OFF_BAR + 14080;
constexpr size_t WS_NEED = OFF_RSS + (size_t)T_ALL * 4;
constexpr size_t OFF_QP = OFF_R2;
constexpr size_t OFF_EIDX = OFF_PGDN;
constexpr size_t OFF_GATE = OFF_EIDX + (size_t)T_ALL * 128 * 4;
constexpr size_t OFF_O = OFF_PGDN;
constexpr size_t OFF_UB = OFF_R1 + (size_t)T_ALL * 512 * 2;
constexpr size_t OFF_H2 = OFF_R3 + 64ull * 1048576;
constexpr size_t OFF_VB = OFF_UB + 16384ull * 1024;
constexpr size_t OFF_USC = OFF_VB + 16384ull * 1024;
constexpr size_t OFF_VSC = OFF_USC + 16384ull * 4;
constexpr size_t OOFF_GB = 0;
constexpr size_t OOFF_GLD = OOFF_GB + (size_t)NCH * 8192;
constexpr size_t OOFF_PSMALL = OOFF_GLD + (size_t)NCH * 64;
constexpr size_t OUT_Y = 0;
constexpr size_t OUT_GLA_P = (size_t)T_ALL * 1024;
constexpr size_t OUT_GDN_P = OUT_GLA_P + 4 * 4 * 64 * 128;
constexpr size_t OUT_CONV_P = OUT_GDN_P + 4 * 4 * 128 * 128;
constexpr size_t OUT_GLA_S = OUT_CONV_P + 4 * 3 * 1536;
constexpr size_t OUT_GDN_S = OUT_GLA_S + 16 * 4 * 64 * 128;
constexpr size_t OUT_CONV_S = OUT_GDN_S + 16 * 4 * 128 * 128;

struct Params {
  const float *x_prompt, *x_sample, *state_gla, *state_gdn, *state_conv, *norm_mix_w, *w_in, *gla_w_gk2, *gla_b_gk,
      *gla_norm_w, *gdn_conv_w, *gdn_a_log, *gdn_dt_bias, *gdn_norm_w, *w_out, *norm_ffn_w, *peer_wq, *peer_k1, *peer_k2,
      *peer_u, *peer_v, *norm_final_w;
  float* out;
  char* ws;
};

DI unsigned pk2(float a, float b) { f32x2 v = {a, b}; bf16x2_t r = __builtin_convertvector(v, bf16x2_t); return __builtin_bit_cast(unsigned, r); }
DI u16 f2bf(float a) { return (u16)(pk2(a, 0.f) & 0xffffu); }
DI float bf2f(u16 v) { return __uint_as_float(((unsigned)v) << 16); }
DI float bflo(unsigned v) { return __uint_as_float(v << 16); }
DI float bfhi(unsigned v) { return __uint_as_float(v & 0xffff0000u); }
DI int crow(int reg, int h) { return (reg & 3) + 8 * (reg >> 2) + 4 * h; }
DI float wave_sum(float v) {
#pragma unroll
  for (int o = 32; o > 0; o >>= 1) v += __shfl_xor(v, o);
  return v;
}
DI float sigmoidf_(float x) { return __builtin_amdgcn_rcpf(1.f + __expf(-x)); }
DI float softplusf_(float x) { return x > 20.f ? x : log1pf(__expf(x)); }
DI const float* xrow(const Params& p, int tok) { return tok < T_P ? p.x_prompt + (size_t)tok * 1024 : p.x_sample + (size_t)(tok - T_P) * 1024; }
DI bf16x8 pack8(const f32x16& x, int s) {
  u32x4 q;
  q.x = pk2(x[8 * s + 0], x[8 * s + 1]); q.y = pk2(x[8 * s + 2], x[8 * s + 3]);
  q.z = pk2(x[8 * s + 4], x[8 * s + 5]); q.w = pk2(x[8 * s + 6], x[8 * s + 7]);
  return __builtin_bit_cast(bf16x8, q);
}
#define LDS_BARRIER() do { asm volatile("s_waitcnt lgkmcnt(0)" ::: "memory"); __builtin_amdgcn_s_barrier(); asm volatile("" ::: "memory"); } while (0)
#define MFMA(a, b, c) __builtin_amdgcn_mfma_f32_32x32x16_bf16((a), (b), (c), 0, 0, 0)

template <int KSTEPS, class FA, class FB>
DI void mma_tile(f32x16& acc, FA fa, FB fb, int r, int h) {
#pragma unroll
  for (int s = 0; s < KSTEPS; ++s) {
    bf16x8 a, b;
#pragma unroll
    for (int j = 0; j < 8; ++j) {
      const int k = 16 * s + 8 * h + j;
      a[j] = (short)fa(r, k);
      b[j] = (short)fb(k, r);
    }
    acc = MFMA(a, b, acc);
  }
}

template <int KSTEPS>
DI void mma_tile_vec(f32x16& acc, const u16* A, int lda, const u16* B, int ldb, int r, int h) {
#pragma unroll
  for (int s = 0; s < KSTEPS; ++s) {
    const bf16x8 a = *(const bf16x8*)(A + r * lda + 16 * s + 8 * h);
    const bf16x8 b = *(const bf16x8*)(B + r * ldb + 16 * s + 8 * h);
    acc = MFMA(a, b, acc);
  }
}

DI void unpack16(const uint4& a, const uint4& b, float* f) {
  f[0] = bflo(a.x); f[1] = bfhi(a.x); f[2] = bflo(a.y); f[3] = bfhi(a.y); f[4] = bflo(a.z); f[5] = bfhi(a.z); f[6] = bflo(a.w); f[7] = bfhi(a.w);
  f[8] = bflo(b.x); f[9] = bfhi(b.x); f[10] = bflo(b.y); f[11] = bfhi(b.y); f[12] = bflo(b.z); f[13] = bfhi(b.z); f[14] = bflo(b.w); f[15] = bfhi(b.w);
}

DI int win_orig_col(int n) {
  if (n < 1024) return n;
  if (n < 1536) return 1040 + (n - 1024);
  if (n < 2048) return 3096 + (n - 1536);
  if (n < 3584) return 1552 + (n - 2048);
  if (n < 3600) return 1024 + (n - 3584);
  if (n < 3604) return 3088 + (n - 3600);
  if (n < 3608) return 3092 + (n - 3604);
  return -1;
}

DI void transpose_w(const float* __restrict__ w, int ncols_src, int n_dst, bool permute, u16* __restrict__ dst, int gtid, int gn) {
  const int items = n_dst * 128;
  for (int it = gtid; it < items; it += gn) {
    const int n = it % n_dst, kg = it / n_dst;
    const int oc = permute ? win_orig_col(n) : n;
    unsigned q[4];
#pragma unroll
    for (int j = 0; j < 4; ++j) {
      float a = 0.f, b = 0.f;
      if (oc >= 0) { a = w[(size_t)(kg * 8 + 2 * j) * ncols_src + oc]; b = w[(size_t)(kg * 8 + 2 * j + 1) * ncols_src + oc]; }
      q[j] = pk2(a, b);
    }
    *(uint4*)(dst + (size_t)n * 1024 + kg * 8) = make_uint4(q[0], q[1], q[2], q[3]);
  }
}

template <class RowF>
DI void norm_rows(RowF rowf, const float* __restrict__ w, u16* __restrict__ dst) {
  const int lane = threadIdx.x & 63;
  const int gw = blockIdx.x * (NTHR / 64) + (threadIdx.x >> 6), nw = gridDim.x * (NTHR / 64);
  float4 ww[4];
#pragma unroll
  for (int q = 0; q < 4; ++q) ww[q] = ((const float4*)w)[lane + 64 * q];
  for (int tok = gw; tok < T_ALL; tok += 2 * nw) {
    const int tok2 = tok + nw;
    const bool has2 = tok2 < T_ALL;
    const float4* xr = (const float4*)rowf(tok);
    const float4* xr2 = (const float4*)rowf(has2 ? tok2 : tok);
    float4 v[4], v2[4];
    float ss = 0.f, ss2 = 0.f;
#pragma unroll
    for (int q = 0; q < 4; ++q) { v[q] = xr[lane + 64 * q]; v2[q] = xr2[lane + 64 * q]; }
#pragma unroll
    for (int q = 0; q < 4; ++q) {
      ss += v[q].x * v[q].x + v[q].y * v[q].y + v[q].z * v[q].z + v[q].w * v[q].w;
      ss2 += v2[q].x * v2[q].x + v2[q].y * v2[q].y + v2[q].z * v2[q].z + v2[q].w * v2[q].w;
    }
#pragma unroll
    for (int o = 32; o > 0; o >>= 1) { ss += __shfl_xor(ss, o); ss2 += __shfl_xor(ss2, o); }
    const float rs = rsqrtf(ss * (1.f / 1024.f) + 1e-6f), rs2 = rsqrtf(ss2 * (1.f / 1024.f) + 1e-6f);
#pragma unroll
    for (int q = 0; q < 4; ++q) {
      uint2 o;
      o.x = pk2(v[q].x * rs * ww[q].x, v[q].y * rs * ww[q].y);
      o.y = pk2(v[q].z * rs * ww[q].z, v[q].w * rs * ww[q].w);
      *(uint2*)(dst + (size_t)tok * 1024 + 4 * (lane + 64 * q)) = o;
      if (has2) {
        uint2 o2;
        o2.x = pk2(v2[q].x * rs2 * ww[q].x, v2[q].y * rs2 * ww[q].y);
        o2.y = pk2(v2[q].z * rs2 * ww[q].z, v2[q].w * rs2 * ww[q].w);
        *(uint2*)(dst + (size_t)tok2 * 1024 + 4 * (lane + 64 * q)) = o2;
      }
    }
  }
}

DI void convert_f32_bf16(const float* __restrict__ src, u16* __restrict__ dst, size_t n4, int gtid, int gn) {
  for (size_t i = gtid; i < n4; i += gn) {
    const float4 v = ((const float4*)src)[i];
    uint2 o; o.x = pk2(v.x, v.y); o.y = pk2(v.z, v.w);
    ((uint2*)dst)[i] = o;
  }
}

DI void convert_rows_fp8(const float* __restrict__ src, unsigned char* __restrict__ dst, float* __restrict__ sc, int gw, int nw) {
  const int lane = threadIdx.x & 63;
  for (int row = gw; row < 16384; row += nw) {
    const float4* rp = (const float4*)(src + (size_t)row * 1024 + lane * 16);
    float4 v[4];
    float am = 0.f;
#pragma unroll
    for (int q = 0; q < 4; ++q) { v[q] = rp[q]; am = fmaxf(am, fmaxf(fmaxf(fabsf(v[q].x), fabsf(v[q].y)), fmaxf(fabsf(v[q].z), fabsf(v[q].w)))); }
#pragma unroll
    for (int o = 32; o > 0; o >>= 1) am = fmaxf(am, __shfl_xor(am, o));
    const float s = am > 0.f ? 256.f / am : 1.f;
    unsigned w[4];
#pragma unroll
    for (int q = 0; q < 4; ++q) {
      int t = 0;
      t = __builtin_amdgcn_cvt_pk_fp8_f32(v[q].x * s, v[q].y * s, t, false);
      t = __builtin_amdgcn_cvt_pk_fp8_f32(v[q].z * s, v[q].w * s, t, true);
      w[q] = (unsigned)t;
    }
    *(uint4*)(dst + (size_t)row * 1024 + lane * 16) = make_uint4(w[0], w[1], w[2], w[3]);
    if (lane == 0) sc[row] = am > 0.f ? am * (1.f / 256.f) : 1.f;
  }
}

DI void phase0(const Params& p) {
  const int gtid = blockIdx.x * NTHR + threadIdx.x, gn = gridDim.x * NTHR;
  transpose_w(p.w_in, 3608, 3840, true, (u16*)(p.ws + OFF_WIN), gtid, gn);
  transpose_w(p.w_out, 1024, 1024, false, (u16*)(p.ws + OFF_WOUT), gtid, gn);
  transpose_w(p.peer_wq, 2048, 2048, false, (u16*)(p.ws + OFF_WQ), gtid, gn);
  convert_f32_bf16(p.peer_k1, (u16*)(p.ws + OFF_K12), 8 * 128 * 128 / 4, gtid, gn);
  convert_f32_bf16(p.peer_k2, (u16*)(p.ws + OFF_K12) + 8 * 128 * 128, 8 * 128 * 128 / 4, gtid, gn);
  norm_rows([&](int tok) { return xrow(p, tok); }, p.norm_mix_w, (u16*)(p.ws + OFF_R1));
}

template <int LD>
DI void store_tile_bf16(u16* ptr, const f32x16 (&acc)[2][2]) {
#pragma unroll
  for (int mi = 0; mi < 2; ++mi)
#pragma unroll
    for (int g = 0; g < 4; ++g) {
#pragma unroll
      for (int j = 0; j < 4; ++j) {
        u16* q = ptr + (size_t)(mi * 32 + 8 * g + j) * LD;
        asm volatile("" : "+v"(q));
        q[0] = f2bf(acc[mi][0][4 * g + j]);
        q[32] = f2bf(acc[mi][1][4 * g + j]);
      }
    }
}

template <class Epi>
DI void gemm_phase(const u16* __restrict__ A, const u16* __restrict__ Bt, int N, Epi epi, char* smem) {
  constexpr int LS = 72;
  u16* sA0 = (u16*)smem;
  u16* sB0 = sA0 + 256 * LS;
  u16* sA1 = sB0 + 128 * LS;
  u16* sB1 = sA1 + 256 * LS;
  const int tid = threadIdx.x, lane = tid & 63, wid = tid >> 6, r = lane & 31, h = lane >> 5;
  const int wm = wid >> 1, wn = wid & 1;
  const int NTN = N / 128;
  const int ntiles = 130 * NTN;
  const int xcd = blockIdx.x & 7, cu = blockIdx.x >> 3, ncu = gridDim.x >> 3;
  auto tile_ptrs = [&](int tile, int& mt, int& nt) {
    const int grp = tile / (4 * NTN), idg = tile % (4 * NTN);
    const int gsz = (130 - grp * 4) < 4 ? (130 - grp * 4) : 4;
    mt = grp * 4 + idg % gsz; nt = idg / gsz;
  };
  uint4 p0, p1, p2, p3, p4, p5, q0, q1, q2, q3, q4, q5;
  const int so = (tid >> 3) * LS + (tid & 7) * 8;
  const size_t toff = (size_t)(tid >> 3) * 1024 + (tid & 7) * 8;
  bool first = true;
  for (int base = xcd * ncu; base < ntiles; base += 8 * ncu) {
    const int tile = base + cu;
    if (tile >= ntiles) break;
    int mt, nt, mtn, ntn;
    tile_ptrs(tile, mt, nt);
    const int tnext = (tile + 8 * ncu < ntiles) ? tile + 8 * ncu : tile;
    tile_ptrs(tnext, mtn, ntn);
    const u16* gA = A + (size_t)mt * 256 * 1024 + toff;
    const u16* gB = Bt + (size_t)nt * 128 * 1024 + toff;
    const u16* gAn = A + (size_t)mtn * 256 * 1024 + toff;
    const u16* gBn = Bt + (size_t)ntn * 128 * 1024 + toff;
    f32x16 acc[2][2];
#pragma unroll
    for (int a = 0; a < 2; ++a)
#pragma unroll
      for (int b = 0; b < 2; ++b)
#pragma unroll
        for (int i = 0; i < 16; ++i) acc[a][b][i] = 0.f;
#define GLOAD(a0, a1, a2, a3, b0, b1, pA, pB, kt)                                                          \
  {                                                                                                        \
    a0 = *(const uint4*)(pA + (kt) * 64); a1 = *(const uint4*)(pA + (kt) * 64 + 64 * 1024);                \
    a2 = *(const uint4*)(pA + (kt) * 64 + 128 * 1024); a3 = *(const uint4*)(pA + (kt) * 64 + 192 * 1024);  \
    b0 = *(const uint4*)(pB + (kt) * 64); b1 = *(const uint4*)(pB + (kt) * 64 + 64 * 1024);                \
  }
#define SSTORE(a0, a1, a2, a3, b0, b1, sA, sB)                                                             \
  {                                                                                                        \
    *(uint4*)((sA) + so) = a0; *(uint4*)((sA) + so + 64 * LS) = a1; *(uint4*)((sA) + so + 128 * LS) = a2;  \
    *(uint4*)((sA) + so + 192 * LS) = a3; *(uint4*)((sB) + so) = b0; *(uint4*)((sB) + so + 64 * LS) = b1;  \
  }
#define LDFR(fa, fb, cA, cB, ks)                                                                          \
  {                                                                                                        \
    _Pragma("unroll") for (int mi = 0; mi < 2; ++mi) fa[mi] = *(const bf16x8*)((cA) + (wm * 64 + mi * 32 + r) * LS + (ks) * 16 + h * 8); \
    _Pragma("unroll") for (int ni = 0; ni < 2; ++ni) fb[ni] = *(const bf16x8*)((cB) + (wn * 64 + ni * 32 + r) * LS + (ks) * 16 + h * 8); \
  }
#define MMA4(fa, fb)                                                                                       \
  {                                                                                                        \
    _Pragma("unroll") for (int mi = 0; mi < 2; ++mi)                                                       \
      _Pragma("unroll") for (int ni = 0; ni < 2; ++ni) acc[mi][ni] = MFMA(fa[mi], fb[ni], acc[mi][ni]);    \
  }
#define COMPUTE(cA, cB, x0, x1, x2, x3, x4, x5, oA, oB)                                                    \
  {                                                                                                        \
    bf16x8 fa0[2], fb0[2], fa1[2], fb1[2];                                                                 \
    LDFR(fa0, fb0, cA, cB, 0);                                                                             \
    LDFR(fa1, fb1, cA, cB, 1); __builtin_amdgcn_sched_barrier(0);                                          \
    *(uint4*)((oA) + so) = x0; *(uint4*)((oA) + so + 64 * LS) = x1;                                        \
    MMA4(fa0, fb0); __builtin_amdgcn_sched_barrier(0);                                                     \
    LDFR(fa0, fb0, cA, cB, 2);                                                                             \
    *(uint4*)((oA) + so + 128 * LS) = x2; *(uint4*)((oA) + so + 192 * LS) = x3; __builtin_amdgcn_sched_barrier(0); \
    MMA4(fa1, fb1); __builtin_amdgcn_sched_barrier(0);                                                     \
    LDFR(fa1, fb1, cA, cB, 3);                                                                             \
    *(uint4*)((oB) + so) = x4; *(uint4*)((oB) + so + 64 * LS) = x5; __builtin_amdgcn_sched_barrier(0);     \
    MMA4(fa0, fb0); __builtin_amdgcn_sched_barrier(0);                                                     \
    MMA4(fa1, fb1);                                                                                        \
  }
    if (first) {
      GLOAD(p0, p1, p2, p3, p4, p5, gA, gB, 0);
      GLOAD(q0, q1, q2, q3, q4, q5, gA, gB, 1);
      SSTORE(p0, p1, p2, p3, p4, p5, sA0, sB0);
      LDS_BARRIER();
      first = false;
    }
#pragma unroll 1
    for (int kt = 0; kt < 16; kt += 2) {
      const u16* sa = (kt < 14) ? gA : gAn;
      const u16* sb = (kt < 14) ? gB : gBn;
      const int k2 = (kt + 2) & 15;
      GLOAD(p0, p1, p2, p3, p4, p5, sa, sb, k2);
      __builtin_amdgcn_sched_barrier(0);
      COMPUTE(sA0, sB0, q0, q1, q2, q3, q4, q5, sA1, sB1);
      LDS_BARRIER();
      GLOAD(q0, q1, q2, q3, q4, q5, sa, sb, k2 + 1);
      __builtin_amdgcn_sched_barrier(0);
      COMPUTE(sA1, sB1, p0, p1, p2, p3, p4, p5, sA0, sB0);
      LDS_BARRIER();
    }
#undef COMPUTE
#undef LDFR
#undef MMA4
#undef GLOAD
#undef SSTORE
    epi(mt * 256 + wm * 64 + 4 * h, nt * 128 + wn * 64 + r, acc);
  }
}

template <int LD>
DI void store_tile4_bf16(u16* ptr, const f32x16 (&acc)[4][2]) {
#pragma unroll
  for (int mi = 0; mi < 4; ++mi)
#pragma unroll
    for (int g = 0; g < 4; ++g) {
#pragma unroll
      for (int j = 0; j < 4; ++j) {
        u16* q = ptr + (size_t)(mi * 32 + 8 * g + j) * LD;
        asm volatile("" : "+v"(q));
        q[0] = f2bf(acc[mi][0][4 * g + j]);
        q[32] = f2bf(acc[mi][1][4 * g + j]);
      }
    }
}
DI void gemm_in_phase(const Params& p, char* smem) {
  constexpr int LS = 72, NTN = 15, NTM = 130, GM = 4;
  u16* sA0 = (u16*)smem;
  u16* sB0 = sA0 + 256 * LS;
  u16* sA1 = sB0 + 256 * LS;
  u16* sB1 = sA1 + 256 * LS;
  const int tid = threadIdx.x, lane = tid & 63, wid = tid >> 6, r = lane & 31, h = lane >> 5;
  const int wm = wid >> 2, wn = wid & 3;
  const u16* A = (const u16*)(p.ws + OFF_R1);
  const u16* Bt = (const u16*)(p.ws + OFF_WIN);
  const int ntiles = NTM * NTN;
  const int xcd = blockIdx.x & 7, cu = blockIdx.x >> 3, ncu = gridDim.x >> 3;
  for (int base = xcd * ncu; base < ntiles; base += 8 * ncu) {
    const int id = base + cu;
    if (id >= ntiles) break;
    const int grp = id / (GM * NTN), idg = id % (GM * NTN);
    const int gsz = (NTM - grp * GM) < GM ? (NTM - grp * GM) : GM;
    const int mt = grp * GM + idg % gsz, nt = idg / gsz;
    const u16* Ab = A + (size_t)mt * 256 * 1024;
    const u16* Bb = Bt + (size_t)nt * 256 * 1024;
    f32x16 acc[4][2];
#pragma unroll
    for (int a = 0; a < 4; ++a)
#pragma unroll
      for (int b = 0; b < 2; ++b)
#pragma unroll
        for (int i = 0; i < 16; ++i) acc[a][b][i] = 0.f;
    uint4 a0, a1, a2, a3, b0, b1, b2, b3;
    const u16* gA = Ab + (size_t)(tid >> 3) * 1024 + (tid & 7) * 8;
    const u16* gB = Bb + (size_t)(tid >> 3) * 1024 + (tid & 7) * 8;
    const int so = (tid >> 3) * LS + (tid & 7) * 8;
#define GLOAD4(g, x0, x1, x2, x3, kt)                                                                      \
  {                                                                                                        \
    x0 = *(const uint4*)(g + (kt) * 64); x1 = *(const uint4*)(g + (kt) * 64 + 64 * 1024);                  \
    x2 = *(const uint4*)(g + (kt) * 64 + 128 * 1024); x3 = *(const uint4*)(g + (kt) * 64 + 192 * 1024);    \
  }
#define SSTORE4(x0, x1, x2, x3, sX)                                                                        \
  {                                                                                                        \
    *(uint4*)((sX) + so) = x0; *(uint4*)((sX) + so + 64 * LS) = x1; *(uint4*)((sX) + so + 128 * LS) = x2;  \
    *(uint4*)((sX) + so + 192 * LS) = x3;                                                                  \
  }
#define LDFR8(fa, fb, cA, cB, ks)                                                                         \
  {                                                                                                        \
    _Pragma("unroll") for (int mi = 0; mi < 4; ++mi) fa[mi] = *(const bf16x8*)((cA) + (wm * 128 + mi * 32 + r) * LS + (ks) * 16 + h * 8); \
    _Pragma("unroll") for (int ni = 0; ni < 2; ++ni) fb[ni] = *(const bf16x8*)((cB) + (wn * 64 + ni * 32 + r) * LS + (ks) * 16 + h * 8);  \
  }
#define MMA8(fa, fb)                                                                                       \
  {                                                                                                        \
    _Pragma("unroll") for (int mi = 0; mi < 4; ++mi)                                                       \
      _Pragma("unroll") for (int ni = 0; ni < 2; ++ni) acc[mi][ni] = MFMA(fa[mi], fb[ni], acc[mi][ni]);    \
  }
#define COMPUTE8(cA, cB)                                                                                   \
  {                                                                                                        \
    bf16x8 fa0[4], fb0[2], fa1[4], fb1[2];                                                                 \
    LDFR8(fa0, fb0, cA, cB, 0);                                                                            \
    LDFR8(fa1, fb1, cA, cB, 1); __builtin_amdgcn_sched_barrier(0);                                         \
    MMA8(fa0, fb0); __builtin_amdgcn_sched_barrier(0);                                                     \
    LDFR8(fa0, fb0, cA, cB, 2); __builtin_amdgcn_sched_barrier(0);                                         \
    MMA8(fa1, fb1); __builtin_amdgcn_sched_barrier(0);                                                     \
    LDFR8(fa1, fb1, cA, cB, 3); __builtin_amdgcn_sched_barrier(0);                                         \
    MMA8(fa0, fb0); __builtin_amdgcn_sched_barrier(0);                                                     \
    MMA8(fa1, fb1);                                                                                        \
  }
    GLOAD4(gA, a0, a1, a2, a3, 0);
    GLOAD4(gB, b0, b1, b2, b3, 0);
    SSTORE4(a0, a1, a2, a3, sA0);
    SSTORE4(b0, b1, b2, b3, sB0);
    LDS_BARRIER();
#pragma unroll 1
    for (int kt = 0; kt < 16; kt += 2) {
      GLOAD4(gA, a0, a1, a2, a3, kt + 1);
      GLOAD4(gB, b0, b1, b2, b3, kt + 1);
      __builtin_amdgcn_sched_barrier(0);
      COMPUTE8(sA0, sB0);
      SSTORE4(a0, a1, a2, a3, sA1);
      SSTORE4(b0, b1, b2, b3, sB1);
      LDS_BARRIER();
      GLOAD4(gA, a0, a1, a2, a3, kt + 2);
      GLOAD4(gB, b0, b1, b2, b3, kt + 2);
      __builtin_amdgcn_sched_barrier(0);
      COMPUTE8(sA1, sB1);
      SSTORE4(a0, a1, a2, a3, sA0);
      SSTORE4(b0, b1, b2, b3, sB0);
      LDS_BARRIER();
    }
#undef GLOAD4
#undef SSTORE4
#undef COMPUTE8
#undef LDFR8
#undef MMA8
    const int row = mt * 256 + wm * 128 + 4 * h, col = wn * 64 + r;
    if (nt < 4) store_tile4_bf16<1024>((u16*)(p.ws + OFF_PGLA) + (size_t)row * 1024 + nt * 256 + col, acc);
    else if (nt < 8) store_tile4_bf16<1024>((u16*)(p.ws + OFF_PGATE) + (size_t)row * 1024 + (nt - 4) * 256 + col, acc);
    else if (nt < 14) store_tile4_bf16<1536>((u16*)(p.ws + OFF_PGDN) + (size_t)row * 1536 + (nt - 8) * 256 + col, acc);
    else if (wn == 0) {
      float* PSM = p.out + OOFF_PSMALL;
#pragma unroll
      for (int mi = 0; mi < 4; ++mi)
#pragma unroll
        for (int i = 0; i < 16; ++i) PSM[(size_t)(row + mi * 32 + (i & 3) + 8 * (i >> 2)) * 32 + r] = acc[mi][0][i];
    }
  }
}

struct ChunkInfo { int tok0, valid, sample, seq, cl; };
DI ChunkInfo chunk_info(int c) {
  ChunkInfo ci;
  if (c < 512) { ci.tok0 = c * 64; ci.valid = 64; ci.sample = 0; ci.seq = c >> 7; ci.cl = c & 127; }
  else { ci.seq = c - 512; ci.tok0 = T_P + ci.seq * 32; ci.valid = 32; ci.sample = 1; ci.cl = 0; }
  return ci;
}

DI void gdn_prep(const Params& p, int c, int hd, char* smem) {
  constexpr int LD = 136, LT = 72;
  u16* sQ = (u16*)smem;
  u16* sK = sQ + 64 * LD;
  u16* sKbT = sK + 64 * LD;
  u16* sVbT = sKbT + 128 * LT;
  u16* sKtT = sVbT + 128 * LT;
  u16* sT = sKtT + 128 * LT;
  u16* sQK = sT + 64 * LT;
  float* sL = (float*)(sQK + 64 * LT);
  float* sG = sL + 64 * 68;
  float* sBe = sG + 64;
  float* sEk = sBe + 64;
  float* sEg = sEk + 64;
  float* sCW = sEg + 64;
  u16* sTT = (u16*)(sCW + 4 * 384);
  u16* sWT = sKbT;
  u16* sUT = sVbT;
  int tid = threadIdx.x;
  asm volatile("" : "+v"(tid));
  char* ws = p.ws;
  float* outp = p.out;
  asm volatile("" : "+s"(ws), "+s"(outp));
  const int lane = tid & 63, wid = tid >> 6, r = lane & 31, h = lane >> 5;
  const ChunkInfo ci = chunk_info(c);
  const int ch = c * 4 + hd;
  const u16* PGDN = (const u16*)(ws + OFF_PGDN);
  const float* PSM = outp + OOFF_PSMALL;
  if (wid == 0) {
    const int n = lane;
    float la = 0.f, be = 0.f;
    if (n < ci.valid) {
      const int tok = ci.tok0 + n;
      const float da = PSM[(size_t)tok * 32 + 16 + hd], db = PSM[(size_t)tok * 32 + 20 + hd];
      be = sigmoidf_(db);
      la = -__expf(p.gdn_a_log[hd]) * softplusf_(da + p.gdn_dt_bias[hd]);
    }
    float G = la;
#pragma unroll
    for (int off = 1; off < 64; off <<= 1) { const float t = __shfl_up(G, off); if (lane >= off) G += t; }
    const float glast = __shfl(G, 63);
    sG[n] = G; sBe[n] = be; sEk[n] = __expf(glast - G); sEg[n] = __expf(G);
    if (lane == 0) ((float*)(ws + OFF_GDEC))[ch] = __expf(glast);
  }
  for (int e = tid; e < 4 * 384; e += NTHR) {
    const int tap = e / 384, cc = e % 384;
    sCW[e] = p.gdn_conv_w[tap * 1536 + (cc >> 7) * 512 + hd * 128 + (cc & 127)];
  }
  {
    const int n = tid >> 3, g = tid & 7;
    uint4 raw[3][4][2];
#pragma unroll
    for (int part = 0; part < 3; ++part)
#pragma unroll
      for (int i = 0; i < 4; ++i) {
        const int pos = n - 3 + i;
        const int col0 = part * 512 + hd * 128 + g * 16;
        uint4 a = make_uint4(0, 0, 0, 0), b = a;
        if (n < ci.valid) {
          if (pos >= 0 || (!ci.sample && ci.cl > 0)) {
            const uint4* sp = (const uint4*)(PGDN + (size_t)(ci.tok0 + pos) * 1536 + col0);
            a = sp[0]; b = sp[1];
          } else if (ci.sample) {
            const float* cb = p.state_conv + ((size_t)ci.seq * 3 + (3 + pos)) * 1536 + col0;
            a.x = pk2(cb[0], cb[1]); a.y = pk2(cb[2], cb[3]); a.z = pk2(cb[4], cb[5]); a.w = pk2(cb[6], cb[7]);
            b.x = pk2(cb[8], cb[9]); b.y = pk2(cb[10], cb[11]); b.z = pk2(cb[12], cb[13]); b.w = pk2(cb[14], cb[15]);
          }
        }
        raw[part][i][0] = a; raw[part][i][1] = b;
      }
    __syncthreads();
#pragma unroll
    for (int part = 0; part < 3; ++part) {
      float v[16];
#pragma unroll
      for (int j = 0; j < 16; ++j) v[j] = 0.f;
#pragma unroll
      for (int i = 0; i < 4; ++i) {
        float sv[16];
        unpack16(raw[part][i][0], raw[part][i][1], sv);
        const float4* cw = (const float4*)(sCW + i * 384 + part * 128 + g * 16);
#pragma unroll
        for (int q4 = 0; q4 < 4; ++q4) {
          const float4 w4 = cw[q4];
          v[4 * q4] += sv[4 * q4] * w4.x; v[4 * q4 + 1] += sv[4 * q4 + 1] * w4.y; v[4 * q4 + 2] += sv[4 * q4 + 2] * w4.z; v[4 * q4 + 3] += sv[4 * q4 + 3] * w4.w;
        }
      }
#pragma unroll
      for (int j = 0; j < 16; ++j) v[j] = v[j] * __builtin_amdgcn_rcpf(1.f + __expf(-v[j]));
      if (part < 2) {
        float ss = 0.f;
#pragma unroll
        for (int j = 0; j < 16; ++j) ss += v[j] * v[j];
        ss += __shfl_xor(ss, 1); ss += __shfl_xor(ss, 2); ss += __shfl_xor(ss, 4);
        const float sc = rsqrtf(ss + 1e-6f) * (part == 0 ? 0.08838834764831845f : 1.f);
#pragma unroll
        for (int j = 0; j < 16; ++j) v[j] *= sc;
        u16* dst = (part == 0 ? sQ : sK) + n * LD + g * 16;
        uint4 o0, o1;
        o0.x = pk2(v[0], v[1]); o0.y = pk2(v[2], v[3]); o0.z = pk2(v[4], v[5]); o0.w = pk2(v[6], v[7]);
        o1.x = pk2(v[8], v[9]); o1.y = pk2(v[10], v[11]); o1.z = pk2(v[12], v[13]); o1.w = pk2(v[14], v[15]);
        *(uint4*)dst = o0; *(uint4*)(dst + 8) = o1;
      }
      if (part == 1) {
        const float sb = sBe[n] * sEg[n], sk = sEk[n];
#pragma unroll
        for (int j = 0; j < 16; ++j) {
          const float kr = bf2f(f2bf(v[j]));
          sKbT[(g * 16 + j) * LT + n] = f2bf(kr * sb);
          sKtT[(g * 16 + j) * LT + n] = f2bf(kr * sk);
        }
      } else if (part == 2) {
        const float sb = sBe[n];
#pragma unroll
        for (int j = 0; j < 16; ++j) sVbT[(g * 16 + j) * LT + n] = f2bf(bf2f(f2bf(v[j])) * sb);
      }
    }
  }
  __syncthreads();
  {
    const int which = wid >> 2, ti = (wid >> 1) & 1, tj = wid & 1;
    f32x16 acc;
#pragma unroll
    for (int i = 0; i < 16; ++i) acc[i] = 0.f;
    mma_tile_vec<8>(acc, (which ? sQ : sK) + 32 * ti * LD, LD, sK + 32 * tj * LD, LD, r, h);
#pragma unroll
    for (int i = 0; i < 16; ++i) {
      const int n = 32 * ti + crow(i, h), m = 32 * tj + r;
      const float d = __expf(fminf(sG[n] - sG[m], 0.f));
      if (which == 0) sL[n * 68 + m] = (m < n) ? sBe[n] * acc[i] * d : 0.f;
      else sQK[n * LT + m] = (m <= n) ? f2bf(acc[i] * d) : (u16)0;
    }
  }
  __syncthreads();
  if (wid == 0) {
    const int hb = lane >> 5, cl = lane & 31;
    float x[32];
#pragma unroll
    for (int i = 0; i < 32; ++i) x[i] = 0.f;
    const float* sLr = sL + (32 * hb) * 68 + 32 * hb;
    asm volatile("" : "+v"(sLr));
#pragma unroll
    for (int i = 0; i < 32; ++i) {
      float a0 = fmaxf(1.f - fabsf((float)(cl - i)), 0.f), a1 = 0.f, a2 = 0.f, a3 = 0.f;
#pragma unroll
      for (int jj = 0; jj * 4 < i; ++jj) {
        const float4 l = *(const float4*)(sLr + i * 68 + jj * 4);
        a0 -= l.x * x[4 * jj]; a1 -= l.y * x[4 * jj + 1]; a2 -= l.z * x[4 * jj + 2]; a3 -= l.w * x[4 * jj + 3];
      }
      const float a = (a0 + a1) + (a2 + a3);
      x[i] = a;
      sT[(32 * hb + i) * LT + 32 * hb + cl] = f2bf(a);
      if (hb == 0) { sT[i * LT + 32 + cl] = 0; sTT[cl * LT + i] = f2bf(a); }
    }
    f32x16 P;
#pragma unroll
    for (int i = 0; i < 16; ++i) P[i] = 0.f;
#pragma unroll
    for (int s2 = 0; s2 < 2; ++s2) {
      const float4 l0 = *(const float4*)(sL + (32 + r) * 68 + 16 * s2 + 8 * h), l1 = *(const float4*)(sL + (32 + r) * 68 + 16 * s2 + 8 * h + 4);
      u32x4 aw; aw.x = pk2(l0.x, l0.y); aw.y = pk2(l0.z, l0.w); aw.z = pk2(l1.x, l1.y); aw.w = pk2(l1.z, l1.w);
      const bf16x8 a = __builtin_bit_cast(bf16x8, aw);
      const bf16x8 b = *(const bf16x8*)(sTT + r * LT + 16 * s2 + 8 * h);
      P = MFMA(a, b, P);
    }
    f32x16 Q;
#pragma unroll
    for (int i = 0; i < 16; ++i) Q[i] = 0.f;
#pragma unroll
    for (int s2 = 0; s2 < 2; ++s2) {
      const uint2 t0 = *(const uint2*)(sT + (32 + r) * LT + 32 + 16 * s2 + 4 * h), t1 = *(const uint2*)(sT + (32 + r) * LT + 32 + 16 * s2 + 8 + 4 * h);
      u32x4 aw; aw.x = t0.x; aw.y = t0.y; aw.z = t1.x; aw.w = t1.y;
      Q = MFMA(__builtin_bit_cast(bf16x8, aw), pack8(P, s2), Q);
    }
#pragma unroll
    for (int i = 0; i < 16; ++i) sT[(32 + crow(i, h)) * LT + r] = f2bf(-Q[i]);
  } else {
    const int r0 = ch * 16 + (wid - 1);
    float4 tv[3][4];
#pragma unroll
    for (int k = 0; k < 3; ++k) {
      const int row = r0 + 7 * k;
      if (row < ch * 16 + 16 && row < 32768) {
        const float* src = (row < 16384 ? p.peer_u + (size_t)row * 1024 : p.peer_v + (size_t)(row - 16384) * 1024) + lane * 16;
#pragma unroll
        for (int q = 0; q < 4; ++q) tv[k][q] = ((const float4*)src)[q];
      }
    }
#pragma unroll
    for (int k = 0; k < 3; ++k) {
      const int row = r0 + 7 * k;
      if (row < ch * 16 + 16 && row < 32768) {
        float am = 0.f;
#pragma unroll
        for (int q = 0; q < 4; ++q) am = fmaxf(am, fmaxf(fmaxf(fabsf(tv[k][q].x), fabsf(tv[k][q].y)), fmaxf(fabsf(tv[k][q].z), fabsf(tv[k][q].w))));
#pragma unroll
        for (int o = 32; o > 0; o >>= 1) am = fmaxf(am, __shfl_xor(am, o));
        const float sc = am > 0.f ? 256.f / am : 1.f;
        unsigned w4[4];
#pragma unroll
        for (int q = 0; q < 4; ++q) {
          int t = 0;
          t = __builtin_amdgcn_cvt_pk_fp8_f32(tv[k][q].x * sc, tv[k][q].y * sc, t, false);
          t = __builtin_amdgcn_cvt_pk_fp8_f32(tv[k][q].z * sc, tv[k][q].w * sc, t, true);
          w4[q] = (unsigned)t;
        }
        unsigned char* dstb = (unsigned char*)(ws + (row < 16384 ? OFF_UB : OFF_VB)) + (size_t)(row & 16383) * 1024 + lane * 16;
        *(uint4*)dstb = make_uint4(w4[0], w4[1], w4[2], w4[3]);
        if (lane == 0) ((float*)(ws + (row < 16384 ? OFF_USC : OFF_VSC)))[row & 16383] = am > 0.f ? am * (1.f / 256.f) : 1.f;
      }
    }
  }
  __syncthreads();
  {
    f32x16 acc2[2];
#pragma unroll
    for (int z = 0; z < 2; ++z) {
      const int q = wid * 2 + z, which = q >> 3, ti = (q >> 2) & 1, tj = q & 3;
#pragma unroll
      for (int i = 0; i < 16; ++i) acc2[z][i] = 0.f;
      mma_tile_vec<4>(acc2[z], sT + 32 * ti * LT, LT, (which ? sVbT : sKbT) + 32 * tj * LT, LT, r, h);
    }
    __syncthreads();
#pragma unroll
    for (int z = 0; z < 2; ++z) {
      const int q = wid * 2 + z, which = q >> 3, ti = (q >> 2) & 1, tj = q & 3;
      const float sg = which ? 1.f : -1.f;
      u16* dst = (which ? sUT : sWT) + (32 * tj + r) * LT + 32 * ti + 4 * h;
#pragma unroll
      for (int g = 0; g < 4; ++g) {
        uint2 o;
        o.x = pk2(sg * acc2[z][4 * g], sg * acc2[z][4 * g + 1]);
        o.y = pk2(sg * acc2[z][4 * g + 2], sg * acc2[z][4 * g + 3]);
        *(uint2*)(dst + 8 * g) = o;
      }
    }
  }
  __syncthreads();
  char* gi = ws + OFF_GI + (size_t)ch * 98304;
#pragma unroll 1
  for (int q = wid; q < 48; q += 8) {
    f32x16 acc;
#pragma unroll
    for (int i = 0; i < 16; ++i) acc[i] = 0.f;
    if (q < 16) {
      const int t_in = q >> 2, t_out = q & 3;
      mma_tile_vec<4>(acc, sWT + 32 * t_in * LT, LT, sKtT + 32 * t_out * LT, LT, r, h);
#pragma unroll
      for (int s2 = 0; s2 < 2; ++s2) *(bf16x8*)(gi + ((size_t)((t_out * 8 + 2 * t_in + s2) * 64 + lane)) * 16) = pack8(acc, s2);
    } else if (q < 32) {
      const int t = (q - 16) >> 2, we = (q - 16) & 3;
      mma_tile_vec<4>(acc, sKtT + 32 * t * LT, LT, sUT + 32 * we * LT, LT, r, h);
      char* dst = gi + 32768 + ((size_t)((we * 4 + t) * 64 + lane)) * 32;
      *(bf16x8*)dst = pack8(acc, 0); *(bf16x8*)(dst + 16) = pack8(acc, 1);
    } else if (q < 40) {
      const int td = (q - 32) >> 1, tn = (q - 32) & 1;
      const float eg = sEg[32 * tn + r];
#pragma unroll
      for (int g = 0; g < 4; ++g) {
        const uint2 qv = *(const uint2*)(sQ + (32 * tn + r) * LD + 32 * td + 8 * g + 4 * h);
        acc[4 * g] = bflo(qv.x) * eg; acc[4 * g + 1] = bfhi(qv.x) * eg; acc[4 * g + 2] = bflo(qv.y) * eg; acc[4 * g + 3] = bfhi(qv.y) * eg;
      }
      mma_tile_vec<4>(acc, sWT + 32 * td * LT, LT, sQK + 32 * tn * LT, LT, r, h);
#pragma unroll
      for (int s2 = 0; s2 < 2; ++s2) *(bf16x8*)(gi + 65536 + ((size_t)((tn * 8 + 2 * td + s2) * 64 + lane)) * 16) = pack8(acc, s2);
    } else {
      const int tn = (q - 40) >> 2, we = (q - 40) & 3;
      mma_tile_vec<4>(acc, sQK + 32 * tn * LT, LT, sUT + 32 * we * LT, LT, r, h);
      char* dst = gi + 81920 + ((size_t)((we * 2 + tn) * 64 + lane)) * 32;
      *(bf16x8*)dst = pack8(acc, 0); *(bf16x8*)(dst + 16) = pack8(acc, 1);
    }
  }
  __syncthreads();
}

struct GlaLds { u16 *sQ, *sK, *sV; float *sG, *sX; };
DI GlaLds gla_carve(char* smem) {
  GlaLds L;
  L.sQ = (u16*)smem; L.sK = L.sQ + 64 * 72; L.sV = L.sK + 64 * 72;
  L.sG = (float*)(L.sV + 64 * 136); L.sX = L.sG + 64 * 65;
  return L;
}
DI void gla_load(const Params& p, int c, int hd, const GlaLds& L) {
  int tid = threadIdx.x;
  asm volatile("" : "+v"(tid));
  char* ws = p.ws;
  float* outp = p.out;
  asm volatile("" : "+s"(ws), "+s"(outp));
  const ChunkInfo ci = chunk_info(c);
  const u16* PG = (const u16*)(ws + OFF_PGLA);
  const float* PSM = outp + OOFF_PSMALL;
  {
    const int n = tid >> 3, g = tid & 7;
    uint4 q4 = make_uint4(0, 0, 0, 0), k4 = q4, v0 = q4, v1 = q4;
    if (n < ci.valid) {
      const u16* rowp = PG + (size_t)(ci.tok0 + n) * 1024;
      q4 = *(const uint4*)(rowp + hd * 64 + g * 8);
      k4 = *(const uint4*)(rowp + 256 + hd * 64 + g * 8);
      v0 = *(const uint4*)(rowp + 512 + hd * 128 + g * 16);
      v1 = *(const uint4*)(rowp + 512 + hd * 128 + g * 16 + 8);
      q4.x = pk2(bflo(q4.x) * 0.125f, bfhi(q4.x) * 0.125f); q4.y = pk2(bflo(q4.y) * 0.125f, bfhi(q4.y) * 0.125f);
      q4.z = pk2(bflo(q4.z) * 0.125f, bfhi(q4.z) * 0.125f); q4.w = pk2(bflo(q4.w) * 0.125f, bfhi(q4.w) * 0.125f);
    }
    *(uint4*)(L.sQ + n * 72 + g * 8) = q4;
    *(uint4*)(L.sK + n * 72 + g * 8) = k4;
    *(uint4*)(L.sV + n * 136 + g * 16) = v0;
    *(uint4*)(L.sV + n * 136 + g * 16 + 8) = v1;
  }
  for (int e = tid; e < 64 * 16; e += NTHR) {
    const int n = e >> 4, rr = e & 15;
    L.sX[e] = (n < ci.valid) ? PSM[(size_t)(ci.tok0 + n) * 32 + rr] : 0.f;
  }
  __syncthreads();
  {
    const int d = tid & 63, n0 = (tid >> 6) * 8;
    float wk[16];
#pragma unroll
    for (int rr = 0; rr < 16; ++rr) wk[rr] = p.gla_w_gk2[rr * 256 + hd * 64 + d];
    const float bias = p.gla_b_gk[hd * 64 + d];
    float run = 0.f, la[8];
#pragma unroll
    for (int i = 0; i < 8; ++i) {
      const int n = n0 + i;
      float z = bias;
#pragma unroll
      for (int rr = 0; rr < 16; ++rr) z += L.sX[n * 16 + rr] * wk[rr];
      float ls = fminf(z, 0.f) - __logf(1.f + __expf(-fabsf(z)));
      ls = (n < ci.valid) ? ls * (1.f / 16.f) : 0.f;
      run += ls; la[i] = run;
    }
    float* part = L.sX + 1024;
    part[(tid >> 6) * 64 + d] = run;
    __syncthreads();
    float pre = 0.f;
    for (int b = 0; b < (tid >> 6); ++b) pre += part[b * 64 + d];
#pragma unroll
    for (int i = 0; i < 8; ++i) L.sG[(n0 + i) * 65 + d] = la[i] + pre;
  }
  __syncthreads();
}

DI void gla_prep(const Params& p, int c, int hd, char* smem) {
  const GlaLds L = gla_carve(smem);
  int tid = threadIdx.x;
  asm volatile("" : "+v"(tid));
  char* ws = p.ws;
  float* outp = p.out;
  asm volatile("" : "+s"(ws), "+s"(outp));
  const int lane = tid & 63, wid = tid >> 6, r = lane & 31, h = lane >> 5;
  const int ch = c * 4 + hd;
  gla_load(p, c, hd, L);
  const int td = wid >> 2, te = wid & 3;
  f32x16 acc;
#pragma unroll
  for (int i = 0; i < 16; ++i) acc[i] = 0.f;
  mma_tile<4>(acc, [&](int i, int k) { const int d = 32 * td + i; return f2bf(bf2f(L.sK[k * 72 + d]) * __expf(L.sG[63 * 65 + d] - L.sG[k * 65 + d])); },
              [&](int k, int j) { return L.sV[k * 136 + 32 * te + j]; }, r, h);
  float* GB = outp + OOFF_GB + (size_t)ch * 8192;
#pragma unroll
  for (int i = 0; i < 16; ++i) GB[(32 * td + crow(i, h)) * 128 + 32 * te + r] = acc[i];
  if (tid < 64) (outp + OOFF_GLD)[(size_t)ch * 64 + tid] = __expf(L.sG[63 * 65 + tid]);
  __syncthreads();
}

DI void gla_out(const Params& p, int c, int hd, char* smem) {
  const GlaLds L = gla_carve(smem);
  u16* sS = (u16*)(L.sX + 1024 + 512);
  u16* sAtt = sS + 64 * 136;
  float* sO = (float*)(sAtt + 64 * 72);
  int tid = threadIdx.x;
  asm volatile("" : "+v"(tid));
  char* ws = p.ws;
  float* outp = p.out;
  asm volatile("" : "+s"(ws), "+s"(outp));
  const int lane = tid & 63, wid = tid >> 6, r = lane & 31, h = lane >> 5;
  const int ch = c * 4 + hd;
  const ChunkInfo ci = chunk_info(c);
  gla_load(p, c, hd, L);
  {
    const float* GB = outp + OOFF_GB + (size_t)ch * 8192;
    for (int e = tid; e < 64 * 32; e += NTHR) {
      const int d = e >> 5, q4 = e & 31;
      const float4 v = ((const float4*)GB)[e];
      uint2 o; o.x = pk2(v.x, v.y); o.y = pk2(v.z, v.w);
      *(uint2*)(sS + d * 136 + q4 * 4) = o;
    }
  }
  if (wid < 4) {
    const int ti = wid >> 1, tj = wid & 1;
    if (!(ti == 0 && tj == 1)) {
      f32x16 acc;
#pragma unroll
      for (int i = 0; i < 16; ++i) acc[i] = 0.f;
      mma_tile<4>(acc, [&](int i, int k) { const int n = 32 * ti + i; return f2bf(bf2f(L.sQ[n * 72 + k]) * __expf(L.sG[n * 65 + k] - L.sG[32 * 65 + k])); },
                  [&](int k, int j) { const int m = 32 * tj + j; return f2bf(bf2f(L.sK[m * 72 + k]) * __expf(L.sG[32 * 65 + k] - L.sG[m * 65 + k])); }, r, h);
#pragma unroll
      for (int i = 0; i < 16; ++i) { const int n = 32 * ti + crow(i, h), m = 32 * tj + r; sAtt[n * 72 + m] = (m <= n) ? f2bf(acc[i]) : (u16)0; }
    } else {
#pragma unroll
      for (int i = 0; i < 16; ++i) sAtt[(crow(i, h)) * 72 + 32 + r] = 0;
    }
  }
  __syncthreads();
  {
    const int tn = wid >> 2, te = wid & 3;
    f32x16 acc;
#pragma unroll
    for (int i = 0; i < 16; ++i) acc[i] = 0.f;
    mma_tile<4>(acc, [&](int i, int k) { const int n = 32 * tn + i; return f2bf(bf2f(L.sQ[n * 72 + k]) * __expf(L.sG[n * 65 + k])); },
                [&](int k, int j) { return sS[k * 136 + 32 * te + j]; }, r, h);
    mma_tile<4>(acc, [&](int i, int k) { return sAtt[(32 * tn + i) * 72 + k]; },
                [&](int k, int j) { return L.sV[k * 136 + 32 * te + j]; }, r, h);
#pragma unroll
    for (int i = 0; i < 16; ++i) sO[(32 * tn + crow(i, h)) * 132 + 32 * te + r] = acc[i];
  }
  __syncthreads();
  {
    const int n = tid >> 3, g = tid & 7;
    float v[16], ss = 0.f;
#pragma unroll
    for (int j = 0; j < 16; ++j) { v[j] = sO[n * 132 + g * 16 + j]; ss += v[j] * v[j]; }
    ss += __shfl_xor(ss, 1); ss += __shfl_xor(ss, 2); ss += __shfl_xor(ss, 4);
    const float rs = rsqrtf(ss * (1.f / 128.f) + 1e-6f);
    if (n < ci.valid) {
      const int tok = ci.tok0 + n;
      const u16* gp = (const u16*)(ws + OFF_PGATE) + (size_t)tok * 1024 + hd * 128 + g * 16;
      const uint4 g0 = *(const uint4*)gp, g1 = *(const uint4*)(gp + 8);
      const unsigned gg[8] = {g0.x, g0.y, g0.z, g0.w, g1.x, g1.y, g1.z, g1.w};
      unsigned o[8];
#pragma unroll
      for (int j = 0; j < 8; ++j) {
        const float ga = bflo(gg[j]), gb = bfhi(gg[j]);
        const float a = v[2 * j] * rs * p.gla_norm_w[g * 16 + 2 * j] * (ga * __builtin_amdgcn_rcpf(1.f + __expf(-ga)));
        const float b = v[2 * j + 1] * rs * p.gla_norm_w[g * 16 + 2 * j + 1] * (gb * __builtin_amdgcn_rcpf(1.f + __expf(-gb)));
        o[j] = pk2(a, b);
      }
      u16* op = (u16*)(ws + OFF_O) + (size_t)tok * 1024 + hd * 128 + g * 16;
      *(uint4*)op = make_uint4(o[0], o[1], o[2], o[3]);
      *(uint4*)(op + 8) = make_uint4(o[4], o[5], o[6], o[7]);
    }
  }
  __syncthreads();
}

constexpr int PF = 3;
template <int NCHUNKS, int ROLE>
DI void chain_loop(const Params& p, int c0, int sb, int hd, int t, int w, int lane, bf16x8* spbuf) {
  const int r = lane & 31, hh = lane >> 5;
  const bool sample = NCHUNKS == 1;
  const size_t offA = (ROLE == 0 ? (size_t)t * 8192 : 65536 + (size_t)t * 8192) + (size_t)lane * 16;
  const size_t offB = (ROLE == 0 ? 32768 + (size_t)(w * 4 + t) * 2048 : 81920 + (size_t)(w * 2 + t) * 2048) + (size_t)lane * 32;
  f32x16 S;
#pragma unroll
  for (int i = 0; i < 16; ++i)
    S[i] = (sample && ROLE == 0) ? p.state_gdn[((size_t)(sb * 4 + hd) * 128 + 32 * t + crow(i, hh)) * 128 + 32 * w + r] : 0.f;
  const float* GDEC = (const float*)(p.ws + OFF_GDEC);
  u16* O2 = (u16*)(p.ws + OFF_R1);
  bf16x8 ra[PF][8];
  uint4 rb[PF][2];
  float rdec[PF];
#define CH_LOAD(slot, cc)                                                                              \
  if (ROLE != 2) {                                                                                     \
    const int cq_ = (cc) < NCHUNKS ? (cc) : NCHUNKS - 1;                                               \
    const int ch_ = (c0 + cq_) * 4 + hd;                                                               \
    const char* gi_ = p.ws + OFF_GI + (size_t)ch_ * 98304;                                             \
    _Pragma("unroll") for (int ks = 0; ks < 8; ++ks) ra[slot][ks] = *(const bf16x8*)(gi_ + offA + ks * 1024); \
    rb[slot][0] = *(const uint4*)(gi_ + offB); rb[slot][1] = *(const uint4*)(gi_ + offB + 16);        \
    rdec[slot] = GDEC[ch_];                                                                            \
  }
#define CH_STEP(u, c)                                                                                  \
  {                                                                                                    \
    CH_LOAD((u + PF - 1) % PF, (c) + PF - 1);                                                          \
    bf16x8* sp = spbuf + ((c) & 1) * 512;                                                              \
    if (ROLE == 0) { sp[(2 * t) * 64 + lane] = pack8(S, 0); sp[(2 * t + 1) * 64 + lane] = pack8(S, 1); } \
    LDS_BARRIER();                                                                                     \
    if (ROLE != 2) {                                                                                   \
      const unsigned bb[8] = {rb[u][0].x, rb[u][0].y, rb[u][0].z, rb[u][0].w, rb[u][1].x, rb[u][1].y, rb[u][1].z, rb[u][1].w}; \
      const float dec = rdec[u];                                                                       \
      f32x16 acc0;                                                                                     \
      _Pragma("unroll") for (int j = 0; j < 8; ++j) { acc0[2 * j] = S[2 * j] * dec + bflo(bb[j]); acc0[2 * j + 1] = S[2 * j + 1] * dec + bfhi(bb[j]); } \
      _Pragma("unroll") for (int ks = 0; ks < 8; ++ks) acc0 = MFMA(ra[u][ks], sp[ks * 64 + lane], acc0); \
      if (ROLE == 0) {                                                                                 \
        S = acc0;                                                                                      \
      } else {                                                                                         \
        const int tok0_ = sample ? T_P + sb * 32 : (c0 + (c)) * 64;                                    \
        _Pragma("unroll") for (int i = 0; i < 16; ++i) {                                               \
          const int n = 32 * t + crow(i, hh);                                                          \
          if (!sample || n < 32) O2[(size_t)(tok0_ + n) * 512 + hd * 128 + 32 * w + r] = f2bf(acc0[i]); \
        }                                                                                              \
      }                                                                                                \
    }                                                                                                  \
  }
#pragma unroll
  for (int u = 0; u < PF - 1; ++u) { CH_LOAD(u, u); }
  constexpr int NMAIN = (NCHUNKS / PF) * PF;
#pragma unroll 1
  for (int cb = 0; cb < NMAIN; cb += PF) {
    CH_STEP(0, cb);
    CH_STEP(1, cb + 1);
    CH_STEP(2, cb + 2);
  }
  if (NCHUNKS - NMAIN >= 1) CH_STEP(0, NMAIN);
  if (NCHUNKS - NMAIN >= 2) CH_STEP(1, NMAIN + 1);
#undef CH_STEP
#undef CH_LOAD
  if (ROLE == 0) {
    float* dst = p.out + (sample ? OUT_GDN_S : OUT_GDN_P) + (size_t)(sb * 4 + hd) * 16384;
#pragma unroll
    for (int i = 0; i < 16; ++i) dst[(32 * t + crow(i, hh)) * 128 + 32 * w + r] = S[i];
  }
}

template <int NCHUNKS>
DI void gdn_chain2(const Params& p, int chain, int w, char* smem) {
  int tid = threadIdx.x;
  asm volatile("" : "+v"(tid));
  const int lane = tid & 63, wid = __builtin_amdgcn_readfirstlane(tid >> 6);
  bf16x8* spbuf = (bf16x8*)smem;
  int sb, hd, c0;
  if (NCHUNKS != 1) { sb = chain >> 2; hd = chain & 3; c0 = sb * 128; }
  else { sb = (chain - 16) >> 2; hd = (chain - 16) & 3; c0 = 512 + sb; }
  if (wid < 4) chain_loop<NCHUNKS, 0>(p, c0, sb, hd, wid, w, lane, spbuf);
  else if (wid < 6) chain_loop<NCHUNKS, 1>(p, c0, sb, hd, wid - 4, w, lane, spbuf);
  else chain_loop<NCHUNKS, 2>(p, c0, sb, hd, 0, w, lane, spbuf);
  __syncthreads();
}

DI void phase3(const Params& p, char* smem) {
  const int tid = threadIdx.x;
  const int b = blockIdx.x;
  if (b < 64) {
    const int x = b & 7, j = b >> 3;
    gdn_chain2<128>(p, x * 2 + (j >> 2), j & 3, smem);
#ifdef REP_P3
    gdn_chain2<128>(p, x * 2 + (j >> 2), j & 3, smem);
#endif
    for (int u = b; u < 256; u += 64) gdn_chain2<1>(p, 16 + (u >> 2), u & 3, smem);
    return;
  }
  const int nb = gridDim.x - 64;
  const int gt = (b - 64) * NTHR + tid, gn = nb * NTHR;
  float* GB = p.out + OOFF_GB;
  const float* GLD = p.out + OOFF_GLD;
  for (int e = gt; e < 16 * 2048; e += gn) {
    const int sh = e >> 11, de4 = e & 2047, d = de4 >> 5;
    const int seq = sh >> 2, hd = sh & 3;
    float4 S = make_float4(0.f, 0.f, 0.f, 0.f);
    for (int cl = 0; cl < 128; cl += 8) {
      float4 bn[8];
      float dc[8];
#pragma unroll
      for (int u = 0; u < 8; ++u) {
        const int ch = (seq * 128 + cl + u) * 4 + hd;
        bn[u] = ((const float4*)(GB + (size_t)ch * 8192))[de4];
        dc[u] = GLD[(size_t)ch * 64 + d];
      }
#pragma unroll
      for (int u = 0; u < 8; ++u) {
        const int ch = (seq * 128 + cl + u) * 4 + hd;
        ((float4*)(GB + (size_t)ch * 8192))[de4] = S;
        S.x = dc[u] * S.x + bn[u].x; S.y = dc[u] * S.y + bn[u].y; S.z = dc[u] * S.z + bn[u].z; S.w = dc[u] * S.w + bn[u].w;
      }
    }
    ((float4*)(p.out + OUT_GLA_P + (size_t)sh * 8192))[de4] = S;
  }
  for (int e = gt; e < 64 * 2048; e += gn) {
    const int sh = e >> 11, de4 = e & 2047, d = de4 >> 5;
    const int sb = sh >> 2, hd = sh & 3;
    const int ch = (512 + sb) * 4 + hd;
    const float4 S0 = ((const float4*)(p.state_gla + (size_t)sh * 8192))[de4];
    const float4 bnew = ((const float4*)(GB + (size_t)ch * 8192))[de4];
    const float dec = GLD[(size_t)ch * 64 + d];
    ((float4*)(GB + (size_t)ch * 8192))[de4] = S0;
    ((float4*)(p.out + OUT_GLA_S + (size_t)sh * 8192))[de4] = make_float4(dec * S0.x + bnew.x, dec * S0.y + bnew.y, dec * S0.z + bnew.z, dec * S0.w + bnew.w);
  }
  {
    unsigned* ctr = (unsigned*)(p.ws + OFF_BAR);
    asm volatile("s_waitcnt vmcnt(0)" ::: "memory");
    __syncthreads();
    if (tid == 0) {
      __builtin_amdgcn_fence(__ATOMIC_RELEASE, "agent");
      asm volatile("s_waitcnt vmcnt(0)" ::: "memory");
      __hip_atomic_fetch_add(ctr, 1u, __ATOMIC_RELAXED, __HIP_MEMORY_SCOPE_AGENT);
      unsigned sp = 0;
      while (__hip_atomic_load(ctr, __ATOMIC_RELAXED, __HIP_MEMORY_SCOPE_AGENT) < (unsigned)nb) { __builtin_amdgcn_s_sleep(2); if (++sp > (1u << 22)) break; }
      __builtin_amdgcn_fence(__ATOMIC_ACQUIRE, "agent");
      asm volatile("s_waitcnt vmcnt(0)" ::: "memory");
    }
    __syncthreads();
  }
  for (int u = b - 64; u < NCH; u += nb) gla_out(p, u >> 2, u & 3, smem);
}

DI void phase4_misc(const Params& p) {
  const int tid = threadIdx.x, lane = tid & 63;
  for (int i = blockIdx.x * NTHR + tid; i < T_ALL; i += gridDim.x * NTHR) ((float*)(p.ws + OFF_RSS))[i] = 0.f;
  const int gw = blockIdx.x * (NTHR / 64) + (tid >> 6), nw = gridDim.x * (NTHR / 64);
  const u16* O2 = (const u16*)(p.ws + OFF_R1);
  const u16* PGATE = (const u16*)(p.ws + OFF_PGATE);
  u16* O = (u16*)(p.ws + OFF_O);
  for (int tok = gw; tok < T_ALL; tok += nw) {
    const uint4 ov = *(const uint4*)(O2 + (size_t)tok * 512 + lane * 8);
    const uint4 zv = *(const uint4*)(PGATE + (size_t)tok * 1024 + 512 + lane * 8);
    const unsigned oo[4] = {ov.x, ov.y, ov.z, ov.w}, zz[4] = {zv.x, zv.y, zv.z, zv.w};
    float v[8], ss = 0.f;
#pragma unroll
    for (int j = 0; j < 4; ++j) { v[2 * j] = bflo(oo[j]); v[2 * j + 1] = bfhi(oo[j]); ss += v[2 * j] * v[2 * j] + v[2 * j + 1] * v[2 * j + 1]; }
    ss += __shfl_xor(ss, 1); ss += __shfl_xor(ss, 2); ss += __shfl_xor(ss, 4); ss += __shfl_xor(ss, 8);
    const float rs = rsqrtf(ss * (1.f / 128.f) + 1e-6f);
    unsigned o[4];
#pragma unroll
    for (int j = 0; j < 4; ++j) {
      const float za = bflo(zz[j]), zb = bfhi(zz[j]);
      const int e = (lane & 15) * 8 + 2 * j;
      const float a = v[2 * j] * rs * p.gdn_norm_w[e] * (za * __builtin_amdgcn_rcpf(1.f + __expf(-za)));
      const float b = v[2 * j + 1] * rs * p.gdn_norm_w[e + 1] * (zb * __builtin_amdgcn_rcpf(1.f + __expf(-zb)));
      o[j] = pk2(a, b);
    }
    *(uint4*)(O + (size_t)tok * 1024 + 512 + lane * 8) = make_uint4(o[0], o[1], o[2], o[3]);
  }
}

DI void conv_state_out(const Params& p) {
  const int gtid = blockIdx.x * NTHR + threadIdx.x, gn = gridDim.x * NTHR;
  const u16* PGDN = (const u16*)(p.ws + OFF_PGDN);
  for (int e = gtid; e < 4 * 3 * 1536; e += gn) {
    const int col = e % 1536, j = (e / 1536) % 3, b = e / (3 * 1536);
    p.out[OUT_CONV_P + e] = bf2f(PGDN[(size_t)(b * 8192 + 8189 + j) * 1536 + col]);
  }
  for (int e = gtid; e < 16 * 3 * 1536; e += gn) {
    const int col = e % 1536, j = (e / 1536) % 3, b = e / (3 * 1536);
    p.out[OUT_CONV_S + e] = bf2f(PGDN[(size_t)(T_P + b * 32 + 29 + j) * 1536 + col]);
  }
}

DI unsigned dpp_max_row(unsigned v) {
  v = max(v, (unsigned)__builtin_amdgcn_update_dpp(0, (int)v, 0xB1, 0xF, 0xF, false));
  v = max(v, (unsigned)__builtin_amdgcn_update_dpp(0, (int)v, 0x4E, 0xF, 0xF, false));
  v = max(v, (unsigned)__builtin_amdgcn_update_dpp(0, (int)v, 0x141, 0xF, 0xF, false));
  v = max(v, (unsigned)__builtin_amdgcn_update_dpp(0, (int)v, 0x140, 0xF, 0xF, false));
  return v;
}
DI float dpp_sum_row(float v) {
  v += __builtin_bit_cast(float, __builtin_amdgcn_update_dpp(0, __builtin_bit_cast(int, v), 0xB1, 0xF, 0xF, false));
  v += __builtin_bit_cast(float, __builtin_amdgcn_update_dpp(0, __builtin_bit_cast(int, v), 0x4E, 0xF, 0xF, false));
  v += __builtin_bit_cast(float, __builtin_amdgcn_update_dpp(0, __builtin_bit_cast(int, v), 0x141, 0xF, 0xF, false));
  v += __builtin_bit_cast(float, __builtin_amdgcn_update_dpp(0, __builtin_bit_cast(int, v), 0x140, 0xF, 0xF, false));
  return v;
}
DI unsigned mkkey(float f, int c) { unsigned u = __float_as_uint(f); u = (u >> 31) ? ~u : (u | 0x80000000u); return (u & 0xFFFFFF00u) | (unsigned)(255 - c); }
DI float keyval(unsigned k) { const unsigned u = k & 0xFFFFFF00u; return __uint_as_float((u >> 31) ? (u & 0x7FFFFFFFu) : ~u); }
DI int keyidx(unsigned k) { return 255 - (int)(k & 255u); }
DI void ce_desc(unsigned& a, unsigned& b) { const unsigned hi = max(a, b), lo = min(a, b); a = hi; b = lo; }
DI void sort8_desc(unsigned (&k)[8]) {
  ce_desc(k[0], k[1]); ce_desc(k[2], k[3]); ce_desc(k[4], k[5]); ce_desc(k[6], k[7]);
  ce_desc(k[0], k[2]); ce_desc(k[1], k[3]); ce_desc(k[4], k[6]); ce_desc(k[5], k[7]);
  ce_desc(k[1], k[2]); ce_desc(k[5], k[6]);
  ce_desc(k[0], k[4]); ce_desc(k[1], k[5]); ce_desc(k[2], k[6]); ce_desc(k[3], k[7]);
  ce_desc(k[2], k[4]); ce_desc(k[3], k[5]);
  ce_desc(k[1], k[2]); ce_desc(k[3], k[4]); ce_desc(k[5], k[6]);
}
DI unsigned top16_sorted8(unsigned (&k)[8], int l16) {
  unsigned res = 0;
  for (int rnd = 0; rnd < 16; ++rnd) {
    const unsigned m = dpp_max_row(k[0]);
    if (l16 == rnd) res = m;
    const bool win = (k[0] == m);
#pragma unroll
    for (int s = 0; s < 7; ++s) k[s] = win ? k[s + 1] : k[s];
    k[7] = win ? 0u : k[7];
  }
  return res;
}

DI void pop_round(unsigned (&k)[8], unsigned& res, int l16, int rnd) {
  const unsigned m = dpp_max_row(k[0]);
  if (l16 == rnd) res = m;
  const bool win = (k[0] == m);
#pragma unroll
  for (int s = 0; s < 7; ++s) k[s] = win ? k[s + 1] : k[s];
  k[7] = win ? 0u : k[7];
}

DI void peer_select(const Params& p, int tile, int hd, char* smem, bool load_keys) {
  u16* sK1 = (u16*)smem;
  u16* sK2 = sK1 + 128 * 136;
  u16* sQ = sK2 + 128 * 136;
  float* sS = (float*)(sQ + 64 * 264);
  int tid = threadIdx.x;
  asm volatile("" : "+v"(tid));
  char* ws = p.ws;
  float* outp = p.out;
  asm volatile("" : "+s"(ws), "+s"(outp));
  const int lane = tid & 63, wid = tid >> 6, r = lane & 31, h = lane >> 5;
  const u16* QP = (const u16*)(ws + OFF_QP);
  const u16* K12 = (const u16*)(ws + OFF_K12);
  const int tok0 = tile * 64;
  for (int e = tid; e < 64 * 32; e += NTHR) {
    const int n = e >> 5, g = e & 31;
    *(uint4*)(sQ + n * 264 + g * 8) = *(const uint4*)(QP + (size_t)(tok0 + n) * 2048 + hd * 256 + g * 8);
  }
  if (load_keys) {
    for (int e = tid; e < 2 * 128 * 16; e += NTHR) {
      const int which = e >> 11, n = (e >> 4) & 127, g = e & 15;
      *(uint4*)(sK1 + which * 128 * 136 + n * 136 + g * 8) = *(const uint4*)(K12 + ((size_t)(which * 8 + hd) * 128 + n) * 128 + g * 8);
    }
  }
  __syncthreads();
  const int l16 = lane & 15, rowb = lane & 48;
  const int tl0 = wid * 8 + (lane >> 4), tl1 = tl0 + 4;
  unsigned ka[8], kb[8], kc[8], kd[8];
  {
    const int tt = wid >> 2, tk = wid & 3;
    f32x16 acc1, acc2;
#pragma unroll
    for (int i = 0; i < 16; ++i) { acc1[i] = 0.f; acc2[i] = 0.f; }
    mma_tile_vec<8>(acc1, sQ + (32 * tt) * 264, 264, sK1 + (32 * tk) * 136, 136, r, h);
    mma_tile_vec<8>(acc2, sQ + (32 * tt) * 264 + 128, 264, sK2 + (32 * tk) * 136, 136, r, h);
#pragma unroll
    for (int i = 0; i < 16; ++i) sS[(32 * tt + crow(i, h)) * 132 + 32 * tk + r] = acc1[i];
    __syncthreads();
#pragma unroll
    for (int s = 0; s < 8; ++s) { const int cc = s * 16 + l16; ka[s] = mkkey(sS[tl0 * 132 + cc], cc); kc[s] = mkkey(sS[tl1 * 132 + cc], cc); }
    __syncthreads();
#pragma unroll
    for (int i = 0; i < 16; ++i) sS[(32 * tt + crow(i, h)) * 132 + 32 * tk + r] = acc2[i];
    __syncthreads();
#pragma unroll
    for (int s = 0; s < 8; ++s) { const int cc = s * 16 + l16; kb[s] = mkkey(sS[tl0 * 132 + cc], cc); kd[s] = mkkey(sS[tl1 * 132 + cc], cc); }
  }
  int* EIDX = (int*)(ws + OFF_EIDX);
  float* GATE = (float*)(ws + OFF_GATE);
  {
    sort8_desc(ka); sort8_desc(kb); sort8_desc(kc); sort8_desc(kd);
    unsigned ra = 0, rb = 0, rc = 0, rd = 0;
    for (int rnd = 0; rnd < 16; ++rnd) {
      pop_round(ka, ra, l16, rnd); pop_round(kb, rb, l16, rnd); pop_round(kc, rc, l16, rnd); pop_round(kd, rd, l16, rnd);
    }
    const float v1[2] = {keyval(ra), keyval(rc)}, v2[2] = {keyval(rb), keyval(rd)};
    const int i1[2] = {keyidx(ra), keyidx(rc)}, i2[2] = {keyidx(rb), keyidx(rd)};
    int ptr[2] = {0, 0};
    unsigned hk[2], r3[2] = {0u, 0u};
#pragma unroll
    for (int gq = 0; gq < 2; ++gq) hk[gq] = mkkey(__shfl(v1[gq], rowb) + v2[gq], l16);
    for (int rnd = 0; rnd < 16; ++rnd) {
#pragma unroll
      for (int gq = 0; gq < 2; ++gq) {
        const unsigned m = dpp_max_row(hk[gq]);
        if (l16 == rnd) r3[gq] = m;
        ptr[gq] += (hk[gq] == m) ? 1 : 0;
        const float va = __shfl(v1[gq], rowb + (ptr[gq] & 15));
        hk[gq] = (ptr[gq] < 16) ? mkkey(va + v2[gq], ptr[gq] * 16 + l16) : 0u;
      }
    }
#pragma unroll
    for (int gq = 0; gq < 2; ++gq) {
      const int cc = keyidx(r3[gq]);
      const float sc = keyval(r3[gq]);
      const int ia = __shfl(i1[gq], rowb + (cc >> 4)), ib = __shfl(i2[gq], rowb + (cc & 15));
      const float mx = __shfl(sc, rowb);
      const float ex = __expf(sc - mx);
      const float sum = dpp_sum_row(ex);
      const size_t o = ((size_t)(tok0 + (gq ? tl1 : tl0)) * 8 + hd) * 16 + l16;
      EIDX[o] = ia * 128 + ib;
      GATE[o] = ex / sum;
    }
  }
  __syncthreads();
}

DI void unpack_fp8x16(const uint4& a, f32x2* f) {
  f[0] = __builtin_amdgcn_cvt_pk_f32_fp8((int)a.x, false); f[1] = __builtin_amdgcn_cvt_pk_f32_fp8((int)a.x, true);
  f[2] = __builtin_amdgcn_cvt_pk_f32_fp8((int)a.y, false); f[3] = __builtin_amdgcn_cvt_pk_f32_fp8((int)a.y, true);
  f[4] = __builtin_amdgcn_cvt_pk_f32_fp8((int)a.z, false); f[5] = __builtin_amdgcn_cvt_pk_f32_fp8((int)a.z, true);
  f[6] = __builtin_amdgcn_cvt_pk_f32_fp8((int)a.w, false); f[7] = __builtin_amdgcn_cvt_pk_f32_fp8((int)a.w, true);
}
DI float wave_sum_dpp(float v) {
  v = dpp_sum_row(v);
  const int b = __builtin_bit_cast(int, v);
  return __builtin_bit_cast(float, __builtin_amdgcn_readlane(b, 0)) + __builtin_bit_cast(float, __builtin_amdgcn_readlane(b, 16)) +
         __builtin_bit_cast(float, __builtin_amdgcn_readlane(b, 32)) + __builtin_bit_cast(float, __builtin_amdgcn_readlane(b, 48));
}
constexpr int GB8 = 16;
DI void phase8(const Params& p) {
  const int tid = threadIdx.x, lane = tid & 63;
  const int gw = blockIdx.x * (NTHR / 64) + (tid >> 6), nw = gridDim.x * (NTHR / 64);
  const u16* H2 = (const u16*)(p.ws + OFF_H2);
  const unsigned char* UB = (const unsigned char*)(p.ws + OFF_UB);
  const unsigned char* VB = (const unsigned char*)(p.ws + OFF_VB);
  const float* USC = (const float*)(p.ws + OFF_USC);
  const float* VSC = (const float*)(p.ws + OFF_VSC);
  const int* EIDX = (const int*)(p.ws + OFF_EIDX);
  const float* GATE = (const float*)(p.ws + OFF_GATE);
  for (int tok = gw; tok < T_ALL; tok += nw) {
    f32x2 hx[8];
    {
      float t[16];
      const uint4* hp = (const uint4*)(H2 + (size_t)tok * 1024 + lane * 16);
      unpack16(hp[0], hp[1], t);
      const float rsn = rsqrtf(((const float*)(p.ws + OFF_RSS))[tok] * (1.f / 1024.f) + 1e-6f);
#pragma unroll
      for (int j = 0; j < 8; ++j) { hx[j].x = t[2 * j] * rsn; hx[j].y = t[2 * j + 1] * rsn; }
    }
    const int e0 = EIDX[(size_t)tok * 128 + lane], e1 = EIDX[(size_t)tok * 128 + 64 + lane];
    const int g0 = __builtin_bit_cast(int, GATE[(size_t)tok * 128 + lane]), g1 = __builtin_bit_cast(int, GATE[(size_t)tok * 128 + 64 + lane]);
    f32x2 acc[8];
#pragma unroll
    for (int j = 0; j < 8; ++j) { acc[j].x = 0.f; acc[j].y = 0.f; }
    for (int rp = 0; rp < REP_P8; ++rp) {
#pragma unroll
    for (int j = 0; j < 8; ++j) { acc[j].x = 0.f; acc[j].y = 0.f; }
    for (int j0 = 0; j0 < 128; j0 += GB8) {
      const int ee = (j0 < 64) ? e0 : e1, gg = (j0 < 64) ? g0 : g1;
      uint4 uq[GB8], vq[GB8];
      float gt[GB8], us[GB8];
#pragma unroll
      for (int u = 0; u < GB8; ++u) {
        const int e = __builtin_amdgcn_readlane(ee, (j0 & 63) + u);
        const float g = __builtin_bit_cast(float, __builtin_amdgcn_readlane(gg, (j0 & 63) + u));
        uq[u] = *(const uint4*)(UB + (size_t)e * 1024 + lane * 16);
        vq[u] = *(const uint4*)(VB + (size_t)e * 1024 + lane * 16);
        gt[u] = g * VSC[e];
        us[u] = USC[e];
      }
#pragma unroll
      for (int u = 0; u < GB8; ++u) {
        f32x2 f[8];
        unpack_fp8x16(uq[u], f);
        f32x2 d2 = f[0] * hx[0];
#pragma unroll
        for (int j = 1; j < 8; ++j) d2 += f[j] * hx[j];
        float d = wave_sum_dpp(d2.x + d2.y) * us[u];
        const float z = 1.5957691216057308f * (d + 0.044715f * d * d * d);
        const float act = d * __builtin_amdgcn_rcpf(1.f + __expf(-z));
        const float wgt = gt[u] * act;
        unpack_fp8x16(vq[u], f);
#pragma unroll
        for (int j = 0; j < 8; ++j) acc[j] += f[j] * wgt;
      }
    }
    }
    float* yr = p.out + OUT_Y + (size_t)tok * 1024 + lane * 16;
    float y[16], ss = 0.f;
#pragma unroll
    for (int q = 0; q < 4; ++q) {
      const float4 xv = ((const float4*)yr)[q];
      y[4 * q] = xv.x + acc[2 * q].x; y[4 * q + 1] = xv.y + acc[2 * q].y; y[4 * q + 2] = xv.z + acc[2 * q + 1].x; y[4 * q + 3] = xv.w + acc[2 * q + 1].y;
    }
#pragma unroll
    for (int j = 0; j < 16; ++j) ss += y[j] * y[j];
    ss = wave_sum(ss);
    const float rs = rsqrtf(ss * (1.f / 1024.f) + 1e-6f);
#pragma unroll
    for (int q = 0; q < 4; ++q) {
      const float4 ww = ((const float4*)(p.norm_final_w + lane * 16))[q];
      float4 o;
      o.x = y[4 * q] * rs * ww.x; o.y = y[4 * q + 1] * rs * ww.y; o.z = y[4 * q + 2] * rs * ww.z; o.w = y[4 * q + 3] * rs * ww.w;
      ((float4*)yr)[q] = o;
    }
  }
}


#define XB_TMO      128
#define XB_XCNT(j)  (256  + 64 * (j))
#define XB_XSUB(j)  (1280 + 64 * (j))
#define XB_XGEN(j)  (2304 + 64 * (j))
#define XB_TOP      3328
#define XB_TOPGEN   3392
#define XCD_BAR_WORDS 3456
#define XB_SPIN_CAP (1u << 18)
#define LAS __attribute__((address_space(3)))
DI unsigned xb_ld(unsigned* p) { return __hip_atomic_load(p, __ATOMIC_RELAXED, __HIP_MEMORY_SCOPE_AGENT); }
DI unsigned xb_add(unsigned* p, unsigned v) { return __hip_atomic_fetch_add(p, v, __ATOMIC_RELAXED, __HIP_MEMORY_SCOPE_AGENT); }
DI unsigned xb_xcc_id() { return (unsigned)__builtin_amdgcn_s_getreg((3 << 11) | 20) & 0xFu; }
#define XB_SPIN(cond, bar) do { unsigned _sp = 0; while (cond) { __builtin_amdgcn_s_sleep(1); \
    if ((++_sp & 255u) == 0u) { if (xb_ld(&(bar)[XB_TMO])) break; if (_sp > XB_SPIN_CAP) { atomicAdd(&(bar)[XB_TMO], 1u); break; } } } } while (0)
struct XcdBarrier { unsigned* bar; unsigned x; volatile LAS unsigned* st; };
DI XcdBarrier xcd_barrier_post(unsigned* bar, volatile LAS unsigned* st) {
  XcdBarrier b; b.bar = bar; b.x = xb_xcc_id(); b.st = st;
  if (threadIdx.x == 0) (void)xb_add(&bar[XB_XCNT(b.x)], 1u);
  return b;
}
DI void xcd_barrier_complete(unsigned* bar, unsigned x, unsigned& nloc, unsigned& nx) {
  const unsigned G = gridDim.x * gridDim.y * gridDim.z;
  unsigned sum, cnt, mine, sp = 0u;
  for (;;) {
    sum = 0u; cnt = 0u; mine = 0u;
#pragma unroll
    for (unsigned j = 0; j < 16; ++j) { const unsigned c = xb_ld(&bar[XB_XCNT(j)]); sum += c; cnt += (c > 0u) ? 1u : 0u; mine = (j == x) ? c : mine; }
    if (sum == G) break;
    __builtin_amdgcn_s_sleep(1);
    if ((++sp & 255u) == 0u) { if (xb_ld(&bar[XB_TMO])) break; if (sp > XB_SPIN_CAP) { atomicAdd(&bar[XB_TMO], 1u); break; } }
  }
  nloc = mine > 0u ? mine : 1u; nx = cnt > 0u ? cnt : 1u;
}
DI void xcd_barrier(const XcdBarrier& b) {
  asm volatile("s_waitcnt vmcnt(0)" ::: "memory");
  __syncthreads();
  if (threadIdx.x == 0) {
    unsigned* bar = b.bar;
    __builtin_amdgcn_s_waitcnt(0);
    unsigned nloc = b.st[0], nx = b.st[1];
    if (nloc == 0u) { xcd_barrier_complete(bar, b.x, nloc, nx); b.st[0] = nloc; b.st[1] = nx; }
    const unsigned old = xb_add(&bar[XB_XSUB(b.x)], 1u);
    const unsigned gen = old / nloc;
    if (old + 1u == (gen + 1u) * nloc) {
      __builtin_amdgcn_fence(__ATOMIC_RELEASE, "agent");
      asm volatile("s_waitcnt vmcnt(0)" ::: "memory");
      const unsigned og = xb_add(&bar[XB_TOP], 1u);
      const unsigned tg = og / nx;
      if (og + 1u == (tg + 1u) * nx) xb_add(&bar[XB_TOPGEN], 1u);
      else XB_SPIN(xb_ld(&bar[XB_TOPGEN]) == tg, bar);
      __builtin_amdgcn_fence(__ATOMIC_ACQUIRE, "agent");
      xb_add(&bar[XB_XGEN(b.x)], 1u);
      asm volatile("s_waitcnt vmcnt(0)" ::: "memory");
    } else {
      XB_SPIN(xb_ld(&bar[XB_XGEN(b.x)]) == gen, bar);
      __builtin_amdgcn_fence(__ATOMIC_ACQUIRE, "agent");
      asm volatile("s_waitcnt vmcnt(0)" ::: "memory");
    }
  }
  __syncthreads();
}

__global__ void __launch_bounds__(NTHR) mega(Params p) {
  extern __shared__ __attribute__((aligned(16))) char smem[];
  cg::grid_group grid = cg::this_grid();
  __shared__ uint4 xb_words;
  if (threadIdx.x == 0) xb_words = make_uint4(0u, 0u, 0u, 0u);
  __syncthreads();
  if (blockIdx.x == 0) for (int i = threadIdx.x; i < XCD_BAR_WORDS; i += NTHR) ((unsigned*)(p.ws + OFF_BAR))[i] = 0u;
  phase0(p);
  grid.sync();
  const XcdBarrier xb = xcd_barrier_post((unsigned*)(p.ws + OFF_BAR), (volatile LAS unsigned*)&xb_words);
#if REP_P0 > 1
  phase0(p);
  xcd_barrier(xb);
#endif
  for (int rp = 0; rp < REP_P1; ++rp) {
    u16* PGLA = (u16*)(p.ws + OFF_PGLA); u16* PGATE = (u16*)(p.ws + OFF_PGATE); u16* PGDN = (u16*)(p.ws + OFF_PGDN);
    float* PSM = p.out + OOFF_PSMALL;
    gemm_phase((const u16*)(p.ws + OFF_R1), (const u16*)(p.ws + OFF_WIN), 3712,
               [&](int row, int col, const f32x16 (&acc)[2][2]) {
                 const int ct = col & ~127;
                 if (ct < 1024) store_tile_bf16<1024>(PGLA + (size_t)row * 1024 + col, acc);
                 else if (ct < 2048) store_tile_bf16<1024>(PGATE + (size_t)row * 1024 + (col - 1024), acc);
                 else if (ct < 3584) store_tile_bf16<1536>(PGDN + (size_t)row * 1536 + (col - 2048), acc);
                 else if (col < 3616) {
#pragma unroll
                   for (int mi = 0; mi < 2; ++mi)
#pragma unroll
                     for (int i = 0; i < 16; ++i) PSM[(size_t)(row + mi * 32 + (i & 3) + 8 * (i >> 2)) * 32 + (col - 3584)] = acc[mi][0][i];
                 }
               }, smem);
    xcd_barrier(xb);
  }
  conv_state_out(p);
  for (int rp = 0; rp < REP_P2L; ++rp) {
    for (int u = blockIdx.x; u < NCH; u += gridDim.x) gla_prep(p, u >> 2, u & 3, smem);
    if (rp + 1 < REP_P2L) xcd_barrier(xb);
  }
  for (int rp = 0; rp < REP_P2G; ++rp) {
    for (int u = gridDim.x - 1 - blockIdx.x; u < NCH; u += gridDim.x) gdn_prep(p, u >> 2, u & 3, smem);
    if (rp + 1 < REP_P2G) xcd_barrier(xb);
  }
  xcd_barrier(xb);
  phase3(p, smem);
  xcd_barrier(xb);
  for (int rp = 0; rp < REP_P4B; ++rp) {
    phase4_misc(p);
    xcd_barrier(xb);
  }
  for (int rp = 0; rp < REP_P5; ++rp) {
    float* X1 = p.out + OUT_Y;
    u16* H2u = (u16*)(p.ws + OFF_H2);
    float* RSS = (float*)(p.ws + OFF_RSS);
    gemm_phase((const u16*)(p.ws + OFF_O), (const u16*)(p.ws + OFF_WOUT), 1024,
               [&](int row, int col, const f32x16 (&acc)[2][2]) {
                 float* q0 = X1 + (size_t)row * 1024 + col;
                 const float* x0 = xrow(p, row) + col;
                 u16* h0 = H2u + (size_t)row * 1024 + col;
                 const float wf0 = p.norm_ffn_w[col], wf1 = p.norm_ffn_w[col + 32];
                 const int lane_ = threadIdx.x & 63;
#pragma unroll
                 for (int mi = 0; mi < 2; ++mi)
#pragma unroll
                   for (int g = 0; g < 4; ++g)
#pragma unroll
                     for (int j = 0; j < 4; ++j) {
                       size_t off = (size_t)(mi * 32 + 8 * g + j) * 1024;
                       asm volatile("" : "+v"(off));
                       const float v0 = x0[off] + acc[mi][0][4 * g + j], v1 = x0[off + 32] + acc[mi][1][4 * g + j];
                       q0[off] = v0; q0[off + 32] = v1;
                       h0[off] = f2bf(v0 * wf0); h0[off + 32] = f2bf(v1 * wf1);
                       float sq = dpp_sum_row(v0 * v0 + v1 * v1);
                       sq += __shfl_xor(sq, 16);
                       if ((lane_ & 31) == 0) atomicAdd(RSS + row + mi * 32 + 8 * g + j, sq);
                     }
               }, smem);
  xcd_barrier(xb);
  }
  for (int rp = 0; rp < REP_P6; ++rp) {
    u16* QP = (u16*)(p.ws + OFF_QP);
    gemm_phase((const u16*)(p.ws + OFF_H2), (const u16*)(p.ws + OFF_WQ), 2048,
               [&](int row, int col, const f32x16 (&acc)[2][2]) {
                 const float* RSS = (const float*)(p.ws + OFF_RSS);
#pragma unroll
                 for (int mi = 0; mi < 2; ++mi)
#pragma unroll
                   for (int g = 0; g < 4; ++g)
#pragma unroll
                     for (int j = 0; j < 4; ++j) {
                       const int rr = row + mi * 32 + 8 * g + j;
                       const float rs = rsqrtf(RSS[rr] * (1.f / 1024.f) + 1e-6f);
                       u16* q = QP + (size_t)rr * 2048 + col;
                       asm volatile("" : "+v"(q));
                       q[0] = f2bf(acc[mi][0][4 * g + j] * rs);
                       q[32] = f2bf(acc[mi][1][4 * g + j] * rs);
                     }
               }, smem);
  xcd_barrier(xb);
  }
  for (int rp = 0; rp < REP_P7; ++rp) {
    int khd = -1;
    for (int u = blockIdx.x; u < 520 * 8; u += gridDim.x) { peer_select(p, u >> 3, u & 7, smem, (u & 7) != khd); khd = u & 7; }
    xcd_barrier(xb);
  }
#ifdef REP_SYNC
  for (int i = 0; i < REP_SYNC; ++i) xcd_barrier(xb);
#endif
  phase8(p);
}

extern "C" void kernel_launch(void* const* d_in, const int* in_sizes, int n_in, void* d_out, int out_size, void* d_ws,
                              size_t ws_size, hipStream_t stream) {
  static int grid_blocks = 0;
  if (!grid_blocks) {
    int dev = 0, cus = 0, per_cu = 0;
    (void)hipGetDevice(&dev);
    (void)hipDeviceGetAttribute(&cus, hipDeviceAttributeMultiprocessorCount, dev);
    (void)hipFuncSetAttribute((const void*)mega, hipFuncAttributeMaxDynamicSharedMemorySize, (int)LDS_BYTES);
    (void)hipOccupancyMaxActiveBlocksPerMultiprocessor(&per_cu, mega, NTHR, LDS_BYTES);
    if (per_cu < 1) per_cu = 1;
    grid_blocks = cus * per_cu;
    if (ws_size < WS_NEED) fprintf(stderr, "workspace too small: %zu < %zu\n", ws_size, (size_t)WS_NEED);
  }
  Params p{};
  const float** pp = (const float**)&p;
  for (int i = 0; i < 22; ++i) pp[i] = (const float*)d_in[i];
  p.out = (float*)d_out;
  p.ws = (char*)d_ws;
  void* args[] = {&p};
  hipError_t e = hipLaunchCooperativeKernel((void*)mega, dim3(grid_blocks), dim3(NTHR), args, LDS_BYTES, stream);
  if (e != hipSuccess) fprintf(stderr, "cooperative launch failed: %s (grid %d)\n", hipGetErrorString(e), grid_blocks);
}
```

```cpp
#include <hip/hip_runtime.h>
#include <hip/hip_cooperative_groups.h>
#include <cstdio>
#include <cstdint>
namespace cg = cooperative_groups;

#define DI __device__ __forceinline__
typedef unsigned short u16;
typedef short bf16x8 __attribute__((ext_vector_type(8)));
typedef float f32x16 __attribute__((ext_vector_type(16)));
typedef float f32x2 __attribute__((ext_vector_type(2)));
typedef __bf16 bf16x2_t __attribute__((ext_vector_type(2)));
typedef unsigned u32x4 __attribute__((ext_vector_type(4)));

#ifndef REP_P0
#define REP_P0 1
#endif
#ifndef REP_P1
#define REP_P1 1
#endif
#ifndef REP_P2G
#define REP_P2G 1
#endif
#ifndef REP_P2L
#define REP_P2L 1
#endif
#ifndef REP_P3G
#define REP_P3G 1
#endif
#ifndef REP_P4A
#define REP_P4A 1
#endif
#ifndef REP_P4B
#define REP_P4B 1
#endif
#ifndef REP_P5
#define REP_P5 1
#endif
#ifndef REP_P6
#define REP_P6 1
#endif
#ifndef REP_P8
#define REP_P8 1
#endif
#ifndef REP_P7
#define REP_P7 1
#endif
constexpr int NTHR = 512;
constexpr int T_ALL = 33280, T_P = 32768;
constexpr int NCH = 2112;
constexpr size_t LDS_BYTES = 147456;

constexpr size_t OFF_WIN = 0;
constexpr size_t OFF_WOUT = OFF_WIN + 3840ull * 1024 * 2;
constexpr size_t OFF_WQ = OFF_WOUT + 1024ull * 1024 * 2;
constexpr size_t OFF_K12 = OFF_WQ + 2048ull * 1024 * 2;
constexpr size_t OFF_R1 = OFF_K12 + 2ull * 8 * 128 * 128 * 2;
constexpr size_t OFF_R2 = OFF_R1 + (size_t)T_ALL * 1024 * 2;
constexpr size_t OFF_PGLA = OFF_R2;
constexpr size_t OFF_PGATE = OFF_PGLA + (size_t)T_ALL * 1024 * 2;
constexpr size_t OFF_PGDN = OFF_PGATE + (size_t)T_ALL * 1024 * 2;
constexpr size_t OFF_R3 = OFF_PGDN + (size_t)T_ALL * 1536 * 2;
constexpr size_t OFF_GI = OFF_R3;
constexpr size_t OFF_GDEC = OFF_GI + (size_t)NCH * 98304;
constexpr size_t OFF_BAR = (OFF_GDEC + NCH * 4 + 255) / 256 * 256;
constexpr size_t OFF_RSS = OFF_BAR + 14080;
constexpr size_t WS_NEED = OFF_RSS + (size_t)T_ALL * 4;
constexpr size_t OFF_QP = OFF_R2;
constexpr size_t OFF_EIDX = OFF_PGDN;
constexpr size_t OFF_GATE = OFF_EIDX + (size_t)T_ALL * 128 * 4;
constexpr size_t OFF_O = OFF_PGDN;
constexpr size_t OFF_UB = OFF_R1 + (size_t)T_ALL * 512 * 2;
constexpr size_t OFF_H2 = OFF_R3 + 64ull * 1048576;
constexpr size_t OFF_VB = OFF_UB + 16384ull * 1024;
constexpr size_t OFF_USC = OFF_VB + 16384ull * 1024;
constexpr size_t OFF_VSC = OFF_USC + 16384ull * 4;
constexpr size_t OOFF_GB = 0;
constexpr size_t OOFF_GLD = OOFF_GB + (size_t)NCH * 8192;
constexpr size_t OOFF_PSMALL = OOFF_GLD + (size_t)NCH * 64;
constexpr size_t OUT_Y = 0;
constexpr size_t OUT_GLA_P = (size_t)T_ALL * 1024;
constexpr size_t OUT_GDN_P = OUT_GLA_P + 4 * 4 * 64 * 128;
constexpr size_t OUT_CONV_P = OUT_GDN_P + 4 * 4 * 128 * 128;
constexpr size_t OUT_GLA_S = OUT_CONV_P + 4 * 3 * 1536;
constexpr size_t OUT_GDN_S = OUT_GLA_S + 16 * 4 * 64 * 128;
constexpr size_t OUT_CONV_S = OUT_GDN_S + 16 * 4 * 128 * 128;

struct Params {
  const float *x_prompt, *x_sample, *state_gla, *state_gdn, *state_conv, *norm_mix_w, *w_in, *gla_w_gk2, *gla_b_gk,
      *gla_norm_w, *gdn_conv_w, *gdn_a_log, *gdn_dt_bias, *gdn_norm_w, *w_out, *norm_ffn_w, *peer_wq, *peer_k1, *peer_k2,
      *peer_u, *peer_v, *norm_final_w;
  float* out;
  char* ws;
};

DI unsigned pk2(float a, float b) { f32x2 v = {a, b}; bf16x2_t r = __builtin_convertvector(v, bf16x2_t); return __builtin_bit_cast(unsigned, r); }
DI u16 f2bf(float a) { return (u16)(pk2(a, 0.f) & 0xffffu); }
DI float bf2f(u16 v) { return __uint_as_float(((unsigned)v) << 16); }
DI float bflo(unsigned v) { return __uint_as_float(v << 16); }
DI float bfhi(unsigned v) { return __uint_as_float(v & 0xffff0000u); }
DI int crow(int reg, int h) { return (reg & 3) + 8 * (reg >> 2) + 4 * h; }
DI float wave_sum(float v) {
#pragma unroll
  for (int o = 32; o > 0; o >>= 1) v += __shfl_xor(v, o);
  return v;
}
DI float sigmoidf_(float x) { return __builtin_amdgcn_rcpf(1.f + __expf(-x)); }
DI float softplusf_(float x) { return x > 20.f ? x : log1pf(__expf(x)); }
DI const float* xrow(const Params& p, int tok) { return tok < T_P ? p.x_prompt + (size_t)tok * 1024 : p.x_sample + (size_t)(tok - T_P) * 1024; }
DI bf16x8 pack8(const f32x16& x, int s) {
  u32x4 q;
  q.x = pk2(x[8 * s + 0], x[8 * s + 1]); q.y = pk2(x[8 * s + 2], x[8 * s + 3]);
  q.z = pk2(x[8 * s + 4], x[8 * s + 5]); q.w = pk2(x[8 * s + 6], x[8 * s + 7]);
  return __builtin_bit_cast(bf16x8, q);
}
#define LDS_BARRIER() do { asm volatile("s_waitcnt lgkmcnt(0)" ::: "memory"); __builtin_amdgcn_s_barrier(); asm volatile("" ::: "memory"); } while (0)
#define MFMA(a, b, c) __builtin_amdgcn_mfma_f32_32x32x16_bf16((a), (b), (c), 0, 0, 0)

template <int KSTEPS, class FA, class FB>
DI void mma_tile(f32x16& acc, FA fa, FB fb, int r, int h) {
#pragma unroll
  for (int s = 0; s < KSTEPS; ++s) {
    bf16x8 a, b;
#pragma unroll
    for (int j = 0; j < 8; ++j) {
      const int k = 16 * s + 8 * h + j;
      a[j] = (short)fa(r, k);
      b[j] = (short)fb(k, r);
    }
    acc = MFMA(a, b, acc);
  }
}

template <int KSTEPS>
DI void mma_tile_vec(f32x16& acc, const u16* A, int lda, const u16* B, int ldb, int r, int h) {
#pragma unroll
  for (int s = 0; s < KSTEPS; ++s) {
    const bf16x8 a = *(const bf16x8*)(A + r * lda + 16 * s + 8 * h);
    const bf16x8 b = *(const bf16x8*)(B + r * ldb + 16 * s + 8 * h);
    acc = MFMA(a, b, acc);
  }
}

DI void unpack16(const uint4& a, const uint4& b, float* f) {
  f[0] = bflo(a.x); f[1] = bfhi(a.x); f[2] = bflo(a.y); f[3] = bfhi(a.y); f[4] = bflo(a.z); f[5] = bfhi(a.z); f[6] = bflo(a.w); f[7] = bfhi(a.w);
  f[8] = bflo(b.x); f[9] = bfhi(b.x); f[10] = bflo(b.y); f[11] = bfhi(b.y); f[12] = bflo(b.z); f[13] = bfhi(b.z); f[14] = bflo(b.w); f[15] = bfhi(b.w);
}

DI int win_orig_col(int n) {
  if (n < 1024) return n;
  if (n < 1536) return 1040 + (n - 1024);
  if (n < 2048) return 3096 + (n - 1536);
  if (n < 3584) return 1552 + (n - 2048);
  if (n < 3600) return 1024 + (n - 3584);
  if (n < 3604) return 3088 + (n - 3600);
  if (n < 3608) return 3092 + (n - 3604);
  return -1;
}

DI void transpose_w(const float* __restrict__ w, int ncols_src, int n_dst, bool permute, u16* __restrict__ dst, int gtid, int gn) {
  const int items = n_dst * 128;
  for (int it = gtid; it < items; it += gn) {
    const int n = it % n_dst, kg = it / n_dst;
    const int oc = permute ? win_orig_col(n) : n;
    unsigned q[4];
#pragma unroll
    for (int j = 0; j < 4; ++j) {
      float a = 0.f, b = 0.f;
      if (oc >= 0) { a = w[(size_t)(kg * 8 + 2 * j) * ncols_src + oc]; b = w[(size_t)(kg * 8 + 2 * j + 1) * ncols_src + oc]; }
      q[j] = pk2(a, b);
    }
    *(uint4*)(dst + (size_t)n * 1024 + kg * 8) = make_uint4(q[0], q[1], q[2], q[3]);
  }
}

template <class RowF>
DI void norm_rows(RowF rowf, const float* __restrict__ w, u16* __restrict__ dst) {
  const int lane = threadIdx.x & 63;
  const int gw = blockIdx.x * (NTHR / 64) + (threadIdx.x >> 6), nw = gridDim.x * (NTHR / 64);
  float4 ww[4];
#pragma unroll
  for (int q = 0; q < 4; ++q) ww[q] = ((const float4*)w)[lane + 64 * q];
  for (int tok = gw; tok < T_ALL; tok += 2 * nw) {
    const int tok2 = tok + nw;
    const bool has2 = tok2 < T_ALL;
    const float4* xr = (const float4*)rowf(tok);
    const float4* xr2 = (const float4*)rowf(has2 ? tok2 : tok);
    float4 v[4], v2[4];
    float ss = 0.f, ss2 = 0.f;
#pragma unroll
    for (int q = 0; q < 4; ++q) { v[q] = xr[lane + 64 * q]; v2[q] = xr2[lane + 64 * q]; }
#pragma unroll
    for (int q = 0; q < 4; ++q) {
      ss += v[q].x * v[q].x + v[q].y * v[q].y + v[q].z * v[q].z + v[q].w * v[q].w;
      ss2 += v2[q].x * v2[q].x + v2[q].y * v2[q].y + v2[q].z * v2[q].z + v2[q].w * v2[q].w;
    }
#pragma unroll
    for (int o = 32; o > 0; o >>= 1) { ss += __shfl_xor(ss, o); ss2 += __shfl_xor(ss2, o); }
    const float rs = rsqrtf(ss * (1.f / 1024.f) + 1e-6f), rs2 = rsqrtf(ss2 * (1.f / 1024.f) + 1e-6f);
#pragma unroll
    for (int q = 0; q < 4; ++q) {
      uint2 o;
      o.x = pk2(v[q].x * rs * ww[q].x, v[q].y * rs * ww[q].y);
      o.y = pk2(v[q].z * rs * ww[q].z, v[q].w * rs * ww[q].w);
      *(uint2*)(dst + (size_t)tok * 1024 + 4 * (lane + 64 * q)) = o;
      if (has2) {
        uint2 o2;
        o2.x = pk2(v2[q].x * rs2 * ww[q].x, v2[q].y * rs2 * ww[q].y);
        o2.y = pk2(v2[q].z * rs2 * ww[q].z, v2[q].w * rs2 * ww[q].w);
        *(uint2*)(dst + (size_t)tok2 * 1024 + 4 * (lane + 64 * q)) = o2;
      }
    }
  }
}

DI void convert_f32_bf16(const float* __restrict__ src, u16* __restrict__ dst, size_t n4, int gtid, int gn) {
  for (size_t i = gtid; i < n4; i += gn) {
    const float4 v = ((const float4*)src)[i];
    uint2 o; o.x = pk2(v.x, v.y); o.y = pk2(v.z, v.w);
    ((uint2*)dst)[i] = o;
  }
}

DI void convert_rows_fp8(const float* __restrict__ src, unsigned char* __restrict__ dst, float* __restrict__ sc, int gw, int nw) {
  const int lane = threadIdx.x & 63;
  for (int row = gw; row < 16384; row += nw) {
    const float4* rp = (const float4*)(src + (size_t)row * 1024 + lane * 16);
    float4 v[4];
    float am = 0.f;
#pragma unroll
    for (int q = 0; q < 4; ++q) { v[q] = rp[q]; am = fmaxf(am, fmaxf(fmaxf(fabsf(v[q].x), fabsf(v[q].y)), fmaxf(fabsf(v[q].z), fabsf(v[q].w)))); }
#pragma unroll
    for (int o = 32; o > 0; o >>= 1) am = fmaxf(am, __shfl_xor(am, o));
    const float s = am > 0.f ? 256.f / am : 1.f;
    unsigned w[4];
#pragma unroll
    for (int q = 0; q < 4; ++q) {
      int t = 0;
      t = __builtin_amdgcn_cvt_pk_fp8_f32(v[q].x * s, v[q].y * s, t, false);
      t = __builtin_amdgcn_cvt_pk_fp8_f32(v[q].z * s, v[q].w * s, t, true);
      w[q] = (unsigned)t;
    }
    *(uint4*)(dst + (size_t)row * 1024 + lane * 16) = make_uint4(w[0], w[1], w[2], w[3]);
    if (lane == 0) sc[row] = am > 0.f ? am * (1.f / 256.f) : 1.f;
  }
}

DI void phase0(const Params& p) {
  const int gtid = blockIdx.x * NTHR + threadIdx.x, gn = gridDim.x * NTHR;
  transpose_w(p.w_in, 3608, 3840, true, (u16*)(p.ws + OFF_WIN), gtid, gn);
  transpose_w(p.w_out, 1024, 1024, false, (u16*)(p.ws + OFF_WOUT), gtid, gn);
  transpose_w(p.peer_wq, 2048, 2048, false, (u16*)(p.ws + OFF_WQ), gtid, gn);
  convert_f32_bf16(p.peer_k1, (u16*)(p.ws + OFF_K12), 8 * 128 * 128 / 4, gtid, gn);
  convert_f32_bf16(p.peer_k2, (u16*)(p.ws + OFF_K12) + 8 * 128 * 128, 8 * 128 * 128 / 4, gtid, gn);
  norm_rows([&](int tok) { return xrow(p, tok); }, p.norm_mix_w, (u16*)(p.ws + OFF_R1));
}

template <int LD>
DI void store_tile_bf16(u16* ptr, const f32x16 (&acc)[2][2]) {
#pragma unroll
  for (int mi = 0; mi < 2; ++mi)
#pragma unroll
    for (int g = 0; g < 4; ++g) {
#pragma unroll
      for (int j = 0; j < 4; ++j) {
        u16* q = ptr + (size_t)(mi * 32 + 8 * g + j) * LD;
        asm volatile("" : "+v"(q));
        q[0] = f2bf(acc[mi][0][4 * g + j]);
        q[32] = f2bf(acc[mi][1][4 * g + j]);
      }
    }
}

template <class Epi>
DI void gemm_phase(const u16* __restrict__ A, const u16* __restrict__ Bt, int N, Epi epi, char* smem) {
  constexpr int LS = 72;
  u16* sA0 = (u16*)smem;
  u16* sB0 = sA0 + 256 * LS;
  u16* sA1 = sB0 + 128 * LS;
  u16* sB1 = sA1 + 256 * LS;
  const int tid = threadIdx.x, lane = tid & 63, wid = tid >> 6, r = lane & 31, h = lane >> 5;
  const int wm = wid >> 1, wn = wid & 1;
  const int NTN = N / 128;
  const int ntiles = 130 * NTN;
  const int xcd = blockIdx.x & 7, cu = blockIdx.x >> 3, ncu = gridDim.x >> 3;
  auto tile_ptrs = [&](int tile, int& mt, int& nt) {
    const int grp = tile / (4 * NTN), idg = tile % (4 * NTN);
    const int gsz = (130 - grp * 4) < 4 ? (130 - grp * 4) : 4;
    mt = grp * 4 + idg % gsz; nt = idg / gsz;
  };
  uint4 p0, p1, p2, p3, p4, p5, q0, q1, q2, q3, q4, q5;
  const int so = (tid >> 3) * LS + (tid & 7) * 8;
  const size_t toff = (size_t)(tid >> 3) * 1024 + (tid & 7) * 8;
  bool first = true;
  for (int base = xcd * ncu; base < ntiles; base += 8 * ncu) {
    const int tile = base + cu;
    if (tile >= ntiles) break;
    int mt, nt, mtn, ntn;
    tile_ptrs(tile, mt, nt);
    const int tnext = (tile + 8 * ncu < ntiles) ? tile + 8 * ncu : tile;
    tile_ptrs(tnext, mtn, ntn);
    const u16* gA = A + (size_t)mt * 256 * 1024 + toff;
    const u16* gB = Bt + (size_t)nt * 128 * 1024 + toff;
    const u16* gAn = A + (size_t)mtn * 256 * 1024 + toff;
    const u16* gBn = Bt + (size_t)ntn * 128 * 1024 + toff;
    f32x16 acc[2][2];
#pragma unroll
    for (int a = 0; a < 2; ++a)
#pragma unroll
      for (int b = 0; b < 2; ++b)
#pragma unroll
        for (int i = 0; i < 16; ++i) acc[a][b][i] = 0.f;
#define GLOAD(a0, a1, a2, a3, b0, b1, pA, pB, kt)                                                          \
  {                                                                                                        \
    a0 = *(const uint4*)(pA + (kt) * 64); a1 = *(const uint4*)(pA + (kt) * 64 + 64 * 1024);                \
    a2 = *(const uint4*)(pA + (kt) * 64 + 128 * 1024); a3 = *(const uint4*)(pA + (kt) * 64 + 192 * 1024);  \
    b0 = *(const uint4*)(pB + (kt) * 64); b1 = *(const uint4*)(pB + (kt) * 64 + 64 * 1024);                \
  }
#define SSTORE(a0, a1, a2, a3, b0, b1, sA, sB)                                                             \
  {                                                                                                        \
    *(uint4*)((sA) + so) = a0; *(uint4*)((sA) + so + 64 * LS) = a1; *(uint4*)((sA) + so + 128 * LS) = a2;  \
    *(uint4*)((sA) + so + 192 * LS) = a3; *(uint4*)((sB) + so) = b0; *(uint4*)((sB) + so + 64 * LS) = b1;  \
  }
#define LDFR(fa, fb, cA, cB, ks)                                                                          \
  {                                                                                                        \
    _Pragma("unroll") for (int mi = 0; mi < 2; ++mi) fa[mi] = *(const bf16x8*)((cA) + (wm * 64 + mi * 32 + r) * LS + (ks) * 16 + h * 8); \
    _Pragma("unroll") for (int ni = 0; ni < 2; ++ni) fb[ni] = *(const bf16x8*)((cB) + (wn * 64 + ni * 32 + r) * LS + (ks) * 16 + h * 8); \
  }
#define MMA4(fa, fb)                                                                                       \
  {                                                                                                        \
    _Pragma("unroll") for (int mi = 0; mi < 2; ++mi)                                                       \
      _Pragma("unroll") for (int ni = 0; ni < 2; ++ni) acc[mi][ni] = MFMA(fa[mi], fb[ni], acc[mi][ni]);    \
  }
#define COMPUTE(cA, cB, x0, x1, x2, x3, x4, x5, oA, oB)                                                    \
  {                                                                                                        \
    bf16x8 fa0[2], fb0[2], fa1[2], fb1[2];                                                                 \
    LDFR(fa0, fb0, cA, cB, 0);                                                                             \
    LDFR(fa1, fb1, cA, cB, 1); __builtin_amdgcn_sched_barrier(0);                                          \
    *(uint4*)((oA) + so) = x0; *(uint4*)((oA) + so + 64 * LS) = x1;                                        \
    MMA4(fa0, fb0); __builtin_amdgcn_sched_barrier(0);                                                     \
    LDFR(fa0, fb0, cA, cB, 2);                                                                             \
    *(uint4*)((oA) + so + 128 * LS) = x2; *(uint4*)((oA) + so + 192 * LS) = x3; __builtin_amdgcn_sched_barrier(0); \
    MMA4(fa1, fb1); __builtin_amdgcn_sched_barrier(0);                                                     \
    LDFR(fa1, fb1, cA, cB, 3);                                                                             \
    *(uint4*)((oB) + so) = x4; *(uint4*)((oB) + so + 64 * LS) = x5; __builtin_amdgcn_sched_barrier(0);     \
    MMA4(fa0, fb0); __builtin_amdgcn_sched_barrier(0);                                                     \
    MMA4(fa1, fb1);                                                                                        \
  }
    if (first) {
      GLOAD(p0, p1, p2, p3, p4, p5, gA, gB, 0);
      GLOAD(q0, q1, q2, q3, q4, q5, gA, gB, 1);
      SSTORE(p0, p1, p2, p3, p4, p5, sA0, sB0);
      LDS_BARRIER();
      first = false;
    }
#pragma unroll 1
    for (int kt = 0; kt < 16; kt += 2) {
      const u16* sa = (kt < 14) ? gA : gAn;
      const u16* sb = (kt < 14) ? gB : gBn;
      const int k2 = (kt + 2) & 15;
      GLOAD(p0, p1, p2, p3, p4, p5, sa, sb, k2);
      __builtin_amdgcn_sched_barrier(0);
      COMPUTE(sA0, sB0, q0, q1, q2, q3, q4, q5, sA1, sB1);
      LDS_BARRIER();
      GLOAD(q0, q1, q2, q3, q4, q5, sa, sb, k2 + 1);
      __builtin_amdgcn_sched_barrier(0);
      COMPUTE(sA1, sB1, p0, p1, p2, p3, p4, p5, sA0, sB0);
      LDS_BARRIER();
    }
#undef COMPUTE
#undef LDFR
#undef MMA4
#undef GLOAD
#undef SSTORE
    epi(mt * 256 + wm * 64 + 4 * h, nt * 128 + wn * 64 + r, acc);
  }
}

template <int LD>
DI void store_tile4_bf16(u16* ptr, const f32x16 (&acc)[4][2]) {
#pragma unroll
  for (int mi = 0; mi < 4; ++mi)
#pragma unroll
    for (int g = 0; g < 4; ++g) {
#pragma unroll
      for (int j = 0; j < 4; ++j) {
        u16* q = ptr + (size_t)(mi * 32 + 8 * g + j) * LD;
        asm volatile("" : "+v"(q));
        q[0] = f2bf(acc[mi][0][4 * g + j]);
        q[32] = f2bf(acc[mi][1][4 * g + j]);
      }
    }
}
DI void gemm_in_phase(const Params& p, char* smem) {
  constexpr int LS = 72, NTN = 15, NTM = 130, GM = 4;
  u16* sA0 = (u16*)smem;
  u16* sB0 = sA0 + 256 * LS;
  u16* sA1 = sB0 + 256 * LS;
  u16* sB1 = sA1 + 256 * LS;
  const int tid = threadIdx.x, lane = tid & 63, wid = tid >> 6, r = lane & 31, h = lane >> 5;
  const int wm = wid >> 2, wn = wid & 3;
  const u16* A = (const u16*)(p.ws + OFF_R1);
  const u16* Bt = (const u16*)(p.ws + OFF_WIN);
  const int ntiles = NTM * NTN;
  const int xcd = blockIdx.x & 7, cu = blockIdx.x >> 3, ncu = gridDim.x >> 3;
  for (int base = xcd * ncu; base < ntiles; base += 8 * ncu) {
    const int id = base + cu;
    if (id >= ntiles) break;
    const int grp = id / (GM * NTN), idg = id % (GM * NTN);
    const int gsz = (NTM - grp * GM) < GM ? (NTM - grp * GM) : GM;
    const int mt = grp * GM + idg % gsz, nt = idg / gsz;
    const u16* Ab = A + (size_t)mt * 256 * 1024;
    const u16* Bb = Bt + (size_t)nt * 256 * 1024;
    f32x16 acc[4][2];
#pragma unroll
    for (int a = 0; a < 4; ++a)
#pragma unroll
      for (int b = 0; b < 2; ++b)
#pragma unroll
        for (int i = 0; i < 16; ++i) acc[a][b][i] = 0.f;
    uint4 a0, a1, a2, a3, b0, b1, b2, b3;
    const u16* gA = Ab + (size_t)(tid >> 3) * 1024 + (tid & 7) * 8;
    const u16* gB = Bb + (size_t)(tid >> 3) * 1024 + (tid & 7) * 8;
    const int so = (tid >> 3) * LS + (tid & 7) * 8;
#define GLOAD4(g, x0, x1, x2, x3, kt)                                                                      \
  {                                                                                                        \
    x0 = *(const uint4*)(g + (kt) * 64); x1 = *(const uint4*)(g + (kt) * 64 + 64 * 1024);                  \
    x2 = *(const uint4*)(g + (kt) * 64 + 128 * 1024); x3 = *(const uint4*)(g + (kt) * 64 + 192 * 1024);    \
  }
#define SSTORE4(x0, x1, x2, x3, sX)                                                                        \
  {                                                                                                        \
    *(uint4*)((sX) + so) = x0; *(uint4*)((sX) + so + 64 * LS) = x1; *(uint4*)((sX) + so + 128 * LS) = x2;  \
    *(uint4*)((sX) + so + 192 * LS) = x3;                                                                  \
  }
#define LDFR8(fa, fb, cA, cB, ks)                                                                         \
  {                                                                                                        \
    _Pragma("unroll") for (int mi = 0; mi < 4; ++mi) fa[mi] = *(const bf16x8*)((cA) + (wm * 128 + mi * 32 + r) * LS + (ks) * 16 + h * 8); \
    _Pragma("unroll") for (int ni = 0; ni < 2; ++ni) fb[ni] = *(const bf16x8*)((cB) + (wn * 64 + ni * 32 + r) * LS + (ks) * 16 + h * 8);  \
  }
#define MMA8(fa, fb)                                                                                       \
  {                                                                                                        \
    _Pragma("unroll") for (int mi = 0; mi < 4; ++mi)                                                       \
      _Pragma("unroll") for (int ni = 0; ni < 2; ++ni) acc[mi][ni] = MFMA(fa[mi], fb[ni], acc[mi][ni]);    \
  }
#define COMPUTE8(cA, cB)                                                                                   \
  {                                                                                                        \
    bf16x8 fa0[4], fb0[2], fa1[4], fb1[2];                                                                 \
    LDFR8(fa0, fb0, cA, cB, 0);                                                                            \
    LDFR8(fa1, fb1, cA, cB, 1); __builtin_amdgcn_sched_barrier(0);                                         \
    MMA8(fa0, fb0); __builtin_amdgcn_sched_barrier(0);                                                     \
    LDFR8(fa0, fb0, cA, cB, 2); __builtin_amdgcn_sched_barrier(0);                                         \
    MMA8(fa1, fb1); __builtin_amdgcn_sched_barrier(0);                                                     \
    LDFR8(fa1, fb1, cA, cB, 3); __builtin_amdgcn_sched_barrier(0);                                         \
    MMA8(fa0, fb0); __builtin_amdgcn_sched_barrier(0);                                                     \
    MMA8(fa1, fb1);                                                                                        \
  }
    GLOAD4(gA, a0, a1, a2, a3, 0);
    GLOAD4(gB, b0, b1, b2, b3, 0);
    SSTORE4(a0, a1, a2, a3, sA0);
    SSTORE4(b0, b1, b2, b3, sB0);
    LDS_BARRIER();
#pragma unroll 1
    for (int kt = 0; kt < 16; kt += 2) {
      GLOAD4(gA, a0, a1, a2, a3, kt + 1);
      GLOAD4(gB, b0, b1, b2, b3, kt + 1);
      __builtin_amdgcn_sched_barrier(0);
      COMPUTE8(sA0, sB0);
      SSTORE4(a0, a1, a2, a3, sA1);
      SSTORE4(b0, b1, b2, b3, sB1);
      LDS_BARRIER();
      GLOAD4(gA, a0, a1, a2, a3, kt + 2);
      GLOAD4(gB, b0, b1, b2, b3, kt + 2);
      __builtin_amdgcn_sched_barrier(0);
      COMPUTE8(sA1, sB1);
      SSTORE4(a0, a1, a2, a3, sA0);
      SSTORE4(b0, b1, b2, b3, sB0);
      LDS_BARRIER();
    }
#undef GLOAD4
#undef SSTORE4
#undef COMPUTE8
#undef LDFR8
#undef MMA8
    const int row = mt * 256 + wm * 128 + 4 * h, col = wn * 64 + r;
    if (nt < 4) store_tile4_bf16<1024>((u16*)(p.ws + OFF_PGLA) + (size_t)row * 1024 + nt * 256 + col, acc);
    else if (nt < 8) store_tile4_bf16<1024>((u16*)(p.ws + OFF_PGATE) + (size_t)row * 1024 + (nt - 4) * 256 + col, acc);
    else if (nt < 14) store_tile4_bf16<1536>((u16*)(p.ws + OFF_PGDN) + (size_t)row * 1536 + (nt - 8) * 256 + col, acc);
    else if (wn == 0) {
      float* PSM = p.out + OOFF_PSMALL;
#pragma unroll
      for (int mi = 0; mi < 4; ++mi)
#pragma unroll
        for (int i = 0; i < 16; ++i) PSM[(size_t)(row + mi * 32 + (i & 3) + 8 * (i >> 2)) * 32 + r] = acc[mi][0][i];
    }
  }
}

struct ChunkInfo { int tok0, valid, sample, seq, cl; };
DI ChunkInfo chunk_info(int c) {
  ChunkInfo ci;
  if (c < 512) { ci.tok0 = c * 64; ci.valid = 64; ci.sample = 0; ci.seq = c >> 7; ci.cl = c & 127; }
  else { ci.seq = c - 512; ci.tok0 = T_P + ci.seq * 32; ci.valid = 32; ci.sample = 1; ci.cl = 0; }
  return ci;
}

DI void gdn_prep(const Params& p, int c, int hd, char* smem) {
  constexpr int LD = 136, LT = 72;
  u16* sQ = (u16*)smem;
  u16* sK = sQ + 64 * LD;
  u16* sKbT = sK + 64 * LD;
  u16* sVbT = sKbT + 128 * LT;
  u16* sKtT = sVbT + 128 * LT;
  u16* sT = sKtT + 128 * LT;
  u16* sQK = sT + 64 * LT;
  float* sL = (float*)(sQK + 64 * LT);
  float* sG = sL + 64 * 68;
  float* sBe = sG + 64;
  float* sEk = sBe + 64;
  float* sEg = sEk + 64;
  float* sCW = sEg + 64;
  u16* sTT = (u16*)(sCW + 4 * 384);
  u16* sWT = sKbT;
  u16* sUT = sVbT;
  int tid = threadIdx.x;
  asm volatile("" : "+v"(tid));
  char* ws = p.ws;
  float* outp = p.out;
  asm volatile("" : "+s"(ws), "+s"(outp));
  const int lane = tid & 63, wid = tid >> 6, r = lane & 31, h = lane >> 5;
  const ChunkInfo ci = chunk_info(c);
  const int ch = c * 4 + hd;
  const u16* PGDN = (const u16*)(ws + OFF_PGDN);
  const float* PSM = outp + OOFF_PSMALL;
  if (wid == 0) {
    const int n = lane;
    float la = 0.f, be = 0.f;
    if (n < ci.valid) {
      const int tok = ci.tok0 + n;
      const float da = PSM[(size_t)tok * 32 + 16 + hd], db = PSM[(size_t)tok * 32 + 20 + hd];
      be = sigmoidf_(db);
      la = -__expf(p.gdn_a_log[hd]) * softplusf_(da + p.gdn_dt_bias[hd]);
    }
    float G = la;
#pragma unroll
    for (int off = 1; off < 64; off <<= 1) { const float t = __shfl_up(G, off); if (lane >= off) G += t; }
    const float glast = __shfl(G, 63);
    sG[n] = G; sBe[n] = be; sEk[n] = __expf(glast - G); sEg[n] = __expf(G);
    if (lane == 0) ((float*)(ws + OFF_GDEC))[ch] = __expf(glast);
  }
  for (int e = tid; e < 4 * 384; e += NTHR) {
    const int tap = e / 384, cc = e % 384;
    sCW[e] = p.gdn_conv_w[tap * 1536 + (cc >> 7) * 512 + hd * 128 + (cc & 127)];
  }
  {
    const int n = tid >> 3, g = tid & 7;
    uint4 raw[3][4][2];
#pragma unroll
    for (int part = 0; part < 3; ++part)
#pragma unroll
      for (int i = 0; i < 4; ++i) {
        const int pos = n - 3 + i;
        const int col0 = part * 512 + hd * 128 + g * 16;
        uint4 a = make_uint4(0, 0, 0, 0), b = a;
        if (n < ci.valid) {
          if (pos >= 0 || (!ci.sample && ci.cl > 0)) {
            const uint4* sp = (const uint4*)(PGDN + (size_t)(ci.tok0 + pos) * 1536 + col0);
            a = sp[0]; b = sp[1];
          } else if (ci.sample) {
            const float* cb = p.state_conv + ((size_t)ci.seq * 3 + (3 + pos)) * 1536 + col0;
            a.x = pk2(cb[0], cb[1]); a.y = pk2(cb[2], cb[3]); a.z = pk2(cb[4], cb[5]); a.w = pk2(cb[6], cb[7]);
            b.x = pk2(cb[8], cb[9]); b.y = pk2(cb[10], cb[11]); b.z = pk2(cb[12], cb[13]); b.w = pk2(cb[14], cb[15]);
          }
        }
        raw[part][i][0] = a; raw[part][i][1] = b;
      }
    __syncthreads();
#pragma unroll
    for (int part = 0; part < 3; ++part) {
      float v[16];
#pragma unroll
      for (int j = 0; j < 16; ++j) v[j] = 0.f;
#pragma unroll
      for (int i = 0; i < 4; ++i) {
        float sv[16];
        unpack16(raw[part][i][0], raw[part][i][1], sv);
        const float4* cw = (const float4*)(sCW + i * 384 + part * 128 + g * 16);
#pragma unroll
        for (int q4 = 0; q4 < 4; ++q4) {
          const float4 w4 = cw[q4];
          v[4 * q4] += sv[4 * q4] * w4.x; v[4 * q4 + 1] += sv[4 * q4 + 1] * w4.y; v[4 * q4 + 2] += sv[4 * q4 + 2] * w4.z; v[4 * q4 + 3] += sv[4 * q4 + 3] * w4.w;
        }
      }
#pragma unroll
      for (int j = 0; j < 16; ++j) v[j] = v[j] * __builtin_amdgcn_rcpf(1.f + __expf(-v[j]));
      if (part < 2) {
        float ss = 0.f;
#pragma unroll
        for (int j = 0; j < 16; ++j) ss += v[j] * v[j];
        ss += __shfl_xor(ss, 1); ss += __shfl_xor(ss, 2); ss += __shfl_xor(ss, 4);
        const float sc = rsqrtf(ss + 1e-6f) * (part == 0 ? 0.08838834764831845f : 1.f);
#pragma unroll
        for (int j = 0; j < 16; ++j) v[j] *= sc;
        u16* dst = (part == 0 ? sQ : sK) + n * LD + g * 16;
        uint4 o0, o1;
        o0.x = pk2(v[0], v[1]); o0.y = pk2(v[2], v[3]); o0.z = pk2(v[4], v[5]); o0.w = pk2(v[6], v[7]);
        o1.x = pk2(v[8], v[9]); o1.y = pk2(v[10], v[11]); o1.z = pk2(v[12], v[13]); o1.w = pk2(v[14], v[15]);
        *(uint4*)dst = o0; *(uint4*)(dst + 8) = o1;
      }
      if (part == 1) {
        const float sb = sBe[n] * sEg[n], sk = sEk[n];
#pragma unroll
        for (int j = 0; j < 16; ++j) {
          const float kr = bf2f(f2bf(v[j]));
          sKbT[(g * 16 + j) * LT + n] = f2bf(kr * sb);
          sKtT[(g * 16 + j) * LT + n] = f2bf(kr * sk);
        }
      } else if (part == 2) {
        const float sb = sBe[n];
#pragma unroll
        for (int j = 0; j < 16; ++j) sVbT[(g * 16 + j) * LT + n] = f2bf(bf2f(f2bf(v[j])) * sb);
      }
    }
  }
  __syncthreads();
  {
    const int which = wid >> 2, ti = (wid >> 1) & 1, tj = wid & 1;
    f32x16 acc;
#pragma unroll
    for (int i = 0; i < 16; ++i) acc[i] = 0.f;
    mma_tile_vec<8>(acc, (which ? sQ : sK) + 32 * ti * LD, LD, sK + 32 * tj * LD, LD, r, h);
#pragma unroll
    for (int i = 0; i < 16; ++i) {
      const int n = 32 * ti + crow(i, h), m = 32 * tj + r;
      const float d = __expf(fminf(sG[n] - sG[m], 0.f));
      if (which == 0) sL[n * 68 + m] = (m < n) ? sBe[n] * acc[i] * d : 0.f;
      else sQK[n * LT + m] = (m <= n) ? f2bf(acc[i] * d) : (u16)0;
    }
  }
  __syncthreads();
  if (wid == 0) {
    const int hb = lane >> 5, cl = lane & 31;
    float x[32];
#pragma unroll
    for (int i = 0; i < 32; ++i) x[i] = 0.f;
    const float* sLr = sL + (32 * hb) * 68 + 32 * hb;
    asm volatile("" : "+v"(sLr));
#pragma unroll
    for (int i = 0; i < 32; ++i) {
      float a0 = fmaxf(1.f - fabsf((float)(cl - i)), 0.f), a1 = 0.f, a2 = 0.f, a3 = 0.f;
#pragma unroll
      for (int jj = 0; jj * 4 < i; ++jj) {
        const float4 l = *(const float4*)(sLr + i * 68 + jj * 4);
        a0 -= l.x * x[4 * jj]; a1 -= l.y * x[4 * jj + 1]; a2 -= l.z * x[4 * jj + 2]; a3 -= l.w * x[4 * jj + 3];
      }
      const float a = (a0 + a1) + (a2 + a3);
      x[i] = a;
      sT[(32 * hb + i) * LT + 32 * hb + cl] = f2bf(a);
      if (hb == 0) { sT[i * LT + 32 + cl] = 0; sTT[cl * LT + i] = f2bf(a); }
    }
    f32x16 P;
#pragma unroll
    for (int i = 0; i < 16; ++i) P[i] = 0.f;
#pragma unroll
    for (int s2 = 0; s2 < 2; ++s2) {
      const float4 l0 = *(const float4*)(sL + (32 + r) * 68 + 16 * s2 + 8 * h), l1 = *(const float4*)(sL + (32 + r) * 68 + 16 * s2 + 8 * h + 4);
      u32x4 aw; aw.x = pk2(l0.x, l0.y); aw.y = pk2(l0.z, l0.w); aw.z = pk2(l1.x, l1.y); aw.w = pk2(l1.z, l1.w);
      const bf16x8 a = __builtin_bit_cast(bf16x8, aw);
      const bf16x8 b = *(const bf16x8*)(sTT + r * LT + 16 * s2 + 8 * h);
      P = MFMA(a, b, P);
    }
    f32x16 Q;
#pragma unroll
    for (int i = 0; i < 16; ++i) Q[i] = 0.f;
#pragma unroll
    for (int s2 = 0; s2 < 2; ++s2) {
      const uint2 t0 = *(const uint2*)(sT + (32 + r) * LT + 32 + 16 * s2 + 4 * h), t1 = *(const uint2*)(sT + (32 + r) * LT + 32 + 16 * s2 + 8 + 4 * h);
      u32x4 aw; aw.x = t0.x; aw.y = t0.y; aw.z = t1.x; aw.w = t1.y;
      Q = MFMA(__builtin_bit_cast(bf16x8, aw), pack8(P, s2), Q);
    }
#pragma unroll
    for (int i = 0; i < 16; ++i) sT[(32 + crow(i, h)) * LT + r] = f2bf(-Q[i]);
  } else {
    const int r0 = ch * 16 + (wid - 1);
    float4 tv[3][4];
#pragma unroll
    for (int k = 0; k < 3; ++k) {
      const int row = r0 + 7 * k;
      if (row < ch * 16 + 16 && row < 32768) {
        const float* src = (row < 16384 ? p.peer_u + (size_t)row * 1024 : p.peer_v + (size_t)(row - 16384) * 1024) + lane * 16;
#pragma unroll
        for (int q = 0; q < 4; ++q) tv[k][q] = ((const float4*)src)[q];
      }
    }
#pragma unroll
    for (int k = 0; k < 3; ++k) {
      const int row = r0 + 7 * k;
      if (row < ch * 16 + 16 && row < 32768) {
        float am = 0.f;
#pragma unroll
        for (int q = 0; q < 4; ++q) am = fmaxf(am, fmaxf(fmaxf(fabsf(tv[k][q].x), fabsf(tv[k][q].y)), fmaxf(fabsf(tv[k][q].z), fabsf(tv[k][q].w))));
#pragma unroll
        for (int o = 32; o > 0; o >>= 1) am = fmaxf(am, __shfl_xor(am, o));
        const float sc = am > 0.f ? 256.f / am : 1.f;
        unsigned w4[4];
#pragma unroll
        for (int q = 0; q < 4; ++q) {
          int t = 0;
          t = __builtin_amdgcn_cvt_pk_fp8_f32(tv[k][q].x * sc, tv[k][q].y * sc, t, false);
          t = __builtin_amdgcn_cvt_pk_fp8_f32(tv[k][q].z * sc, tv[k][q].w * sc, t, true);
          w4[q] = (unsigned)t;
        }
        unsigned char* dstb = (unsigned char*)(ws + (row < 16384 ? OFF_UB : OFF_VB)) + (size_t)(row & 16383) * 1024 + lane * 16;
        *(uint4*)dstb = make_uint4(w4[0], w4[1], w4[2], w4[3]);
        if (lane == 0) ((float*)(ws + (row < 16384 ? OFF_USC : OFF_VSC)))[row & 16383] = am > 0.f ? am * (1.f / 256.f) : 1.f;
      }
    }
  }
  __syncthreads();
  {
    f32x16 acc2[2];
#pragma unroll
    for (int z = 0; z < 2; ++z) {
      const int q = wid * 2 + z, which = q >> 3, ti = (q >> 2) & 1, tj = q & 3;
#pragma unroll
      for (int i = 0; i < 16; ++i) acc2[z][i] = 0.f;
      mma_tile_vec<4>(acc2[z], sT + 32 * ti * LT, LT, (which ? sVbT : sKbT) + 32 * tj * LT, LT, r, h);
    }
    __syncthreads();
#pragma unroll
    for (int z = 0; z < 2; ++z) {
      const int q = wid * 2 + z, which = q >> 3, ti = (q >> 2) & 1, tj = q & 3;
      const float sg = which ? 1.f : -1.f;
      u16* dst = (which ? sUT : sWT) + (32 * tj + r) * LT + 32 * ti + 4 * h;
#pragma unroll
      for (int g = 0; g < 4; ++g) {
        uint2 o;
        o.x = pk2(sg * acc2[z][4 * g], sg * acc2[z][4 * g + 1]);
        o.y = pk2(sg * acc2[z][4 * g + 2], sg * acc2[z][4 * g + 3]);
        *(uint2*)(dst + 8 * g) = o;
      }
    }
  }
  __syncthreads();
  char* gi = ws + OFF_GI + (size_t)ch * 98304;
#pragma unroll 1
  for (int q = wid; q < 48; q += 8) {
    f32x16 acc;
#pragma unroll
    for (int i = 0; i < 16; ++i) acc[i] = 0.f;
    if (q < 16) {
      const int t_in = q >> 2, t_out = q & 3;
      mma_tile_vec<4>(acc, sWT + 32 * t_in * LT, LT, sKtT + 32 * t_out * LT, LT, r, h);
#pragma unroll
      for (int s2 = 0; s2 < 2; ++s2) *(bf16x8*)(gi + ((size_t)((t_out * 8 + 2 * t_in + s2) * 64 + lane)) * 16) = pack8(acc, s2);
    } else if (q < 32) {
      const int t = (q - 16) >> 2, we = (q - 16) & 3;
      mma_tile_vec<4>(acc, sKtT + 32 * t * LT, LT, sUT + 32 * we * LT, LT, r, h);
      char* dst = gi + 32768 + ((size_t)((we * 4 + t) * 64 + lane)) * 32;
      *(bf16x8*)dst = pack8(acc, 0); *(bf16x8*)(dst + 16) = pack8(acc, 1);
    } else if (q < 40) {
      const int td = (q - 32) >> 1, tn = (q - 32) & 1;
      const float eg = sEg[32 * tn + r];
#pragma unroll
      for (int g = 0; g < 4; ++g) {
        const uint2 qv = *(const uint2*)(sQ + (32 * tn + r) * LD + 32 * td + 8 * g + 4 * h);
        acc[4 * g] = bflo(qv.x) * eg; acc[4 * g + 1] = bfhi(qv.x) * eg; acc[4 * g + 2] = bflo(qv.y) * eg; acc[4 * g + 3] = bfhi(qv.y) * eg;
      }
      mma_tile_vec<4>(acc, sWT + 32 * td * LT, LT, sQK + 32 * tn * LT, LT, r, h);
#pragma unroll
      for (int s2 = 0; s2 < 2; ++s2) *(bf16x8*)(gi + 65536 + ((size_t)((tn * 8 + 2 * td + s2) * 64 + lane)) * 16) = pack8(acc, s2);
    } else {
      const int tn = (q - 40) >> 2, we = (q - 40) & 3;
      mma_tile_vec<4>(acc, sQK + 32 * tn * LT, LT, sUT + 32 * we * LT, LT, r, h);
      char* dst = gi + 81920 + ((size_t)((we * 2 + tn) * 64 + lane)) * 32;
      *(bf16x8*)dst = pack8(acc, 0); *(bf16x8*)(dst + 16) = pack8(acc, 1);
    }
  }
  __syncthreads();
}

struct GlaLds { u16 *sQ, *sK, *sV; float *sG, *sX; };
DI GlaLds gla_carve(char* smem) {
  GlaLds L;
  L.sQ = (u16*)smem; L.sK = L.sQ + 64 * 72; L.sV = L.sK + 64 * 72;
  L.sG = (float*)(L.sV + 64 * 136); L.sX = L.sG + 64 * 65;
  return L;
}
DI void gla_load(const Params& p, int c, int hd, const GlaLds& L) {
  int tid = threadIdx.x;
  asm volatile("" : "+v"(tid));
  char* ws = p.ws;
  float* outp = p.out;
  asm volatile("" : "+s"(ws), "+s"(outp));
  const ChunkInfo ci = chunk_info(c);
  const u16* PG = (const u16*)(ws + OFF_PGLA);
  const float* PSM = outp + OOFF_PSMALL;
  {
    const int n = tid >> 3, g = tid & 7;
    uint4 q4 = make_uint4(0, 0, 0, 0), k4 = q4, v0 = q4, v1 = q4;
    if (n < ci.valid) {
      const u16* rowp = PG + (size_t)(ci.tok0 + n) * 1024;
      q4 = *(const uint4*)(rowp + hd * 64 + g * 8);
      k4 = *(const uint4*)(rowp + 256 + hd * 64 + g * 8);
      v0 = *(const uint4*)(rowp + 512 + hd * 128 + g * 16);
      v1 = *(const uint4*)(rowp + 512 + hd * 128 + g * 16 + 8);
      q4.x = pk2(bflo(q4.x) * 0.125f, bfhi(q4.x) * 0.125f); q4.y = pk2(bflo(q4.y) * 0.125f, bfhi(q4.y) * 0.125f);
      q4.z = pk2(bflo(q4.z) * 0.125f, bfhi(q4.z) * 0.125f); q4.w = pk2(bflo(q4.w) * 0.125f, bfhi(q4.w) * 0.125f);
    }
    *(uint4*)(L.sQ + n * 72 + g * 8) = q4;
    *(uint4*)(L.sK + n * 72 + g * 8) = k4;
    *(uint4*)(L.sV + n * 136 + g * 16) = v0;
    *(uint4*)(L.sV + n * 136 + g * 16 + 8) = v1;
  }
  for (int e = tid; e < 64 * 16; e += NTHR) {
    const int n = e >> 4, rr = e & 15;
    L.sX[e] = (n < ci.valid) ? PSM[(size_t)(ci.tok0 + n) * 32 + rr] : 0.f;
  }
  __syncthreads();
  {
    const int d = tid & 63, n0 = (tid >> 6) * 8;
    float wk[16];
#pragma unroll
    for (int rr = 0; rr < 16; ++rr) wk[rr] = p.gla_w_gk2[rr * 256 + hd * 64 + d];
    const float bias = p.gla_b_gk[hd * 64 + d];
    float run = 0.f, la[8];
#pragma unroll
    for (int i = 0; i < 8; ++i) {
      const int n = n0 + i;
      float z = bias;
#pragma unroll
      for (int rr = 0; rr < 16; ++rr) z += L.sX[n * 16 + rr] * wk[rr];
      float ls = fminf(z, 0.f) - __logf(1.f + __expf(-fabsf(z)));
      ls = (n < ci.valid) ? ls * (1.f / 16.f) : 0.f;
      run += ls; la[i] = run;
    }
    float* part = L.sX + 1024;
    part[(tid >> 6) * 64 + d] = run;
    __syncthreads();
    float pre = 0.f;
    for (int b = 0; b < (tid >> 6); ++b) pre += part[b * 64 + d];
#pragma unroll
    for (int i = 0; i < 8; ++i) L.sG[(n0 + i) * 65 + d] = la[i] + pre;
  }
  __syncthreads();
}

DI void gla_prep(const Params& p, int c, int hd, char* smem) {
  const GlaLds L = gla_carve(smem);
  int tid = threadIdx.x;
  asm volatile("" : "+v"(tid));
  char* ws = p.ws;
  float* outp = p.out;
  asm volatile("" : "+s"(ws), "+s"(outp));
  const int lane = tid & 63, wid = tid >> 6, r = lane & 31, h = lane >> 5;
  const int ch = c * 4 + hd;
  gla_load(p, c, hd, L);
  const int td = wid >> 2, te = wid & 3;
  f32x16 acc;
#pragma unroll
  for (int i = 0; i < 16; ++i) acc[i] = 0.f;
  mma_tile<4>(acc, [&](int i, int k) { const int d = 32 * td + i; return f2bf(bf2f(L.sK[k * 72 + d]) * __expf(L.sG[63 * 65 + d] - L.sG[k * 65 + d])); },
              [&](int k, int j) { return L.sV[k * 136 + 32 * te + j]; }, r, h);
  float* GB = outp + OOFF_GB + (size_t)ch * 8192;
#pragma unroll
  for (int i = 0; i < 16; ++i) GB[(32 * td + crow(i, h)) * 128 + 32 * te + r] = acc[i];
  if (tid < 64) (outp + OOFF_GLD)[(size_t)ch * 64 + tid] = __expf(L.sG[63 * 65 + tid]);
  __syncthreads();
}

DI void gla_out(const Params& p, int c, int hd, char* smem) {
  const GlaLds L = gla_carve(smem);
  u16* sS = (u16*)(L.sX + 1024 + 512);
  u16* sAtt = sS + 64 * 136;
  float* sO = (float*)(sAtt + 64 * 72);
  int tid = threadIdx.x;
  asm volatile("" : "+v"(tid));
  char* ws = p.ws;
  float* outp = p.out;
  asm volatile("" : "+s"(ws), "+s"(outp));
  const int lane = tid & 63, wid = tid >> 6, r = lane & 31, h = lane >> 5;
  const int ch = c * 4 + hd;
  const ChunkInfo ci = chunk_info(c);
  gla_load(p, c, hd, L);
  {
    const float* GB = outp + OOFF_GB + (size_t)ch * 8192;
    for (int e = tid; e < 64 * 32; e += NTHR) {
      const int d = e >> 5, q4 = e & 31;
      const float4 v = ((const float4*)GB)[e];
      uint2 o; o.x = pk2(v.x, v.y); o.y = pk2(v.z, v.w);
      *(uint2*)(sS + d * 136 + q4 * 4) = o;
    }
  }
  if (wid < 4) {
    const int ti = wid >> 1, tj = wid & 1;
    if (!(ti == 0 && tj == 1)) {
      f32x16 acc;
#pragma unroll
      for (int i = 0; i < 16; ++i) acc[i] = 0.f;
      mma_tile<4>(acc, [&](int i, int k) { const int n = 32 * ti + i; return f2bf(bf2f(L.sQ[n * 72 + k]) * __expf(L.sG[n * 65 + k] - L.sG[32 * 65 + k])); },
                  [&](int k, int j) { const int m = 32 * tj + j; return f2bf(bf2f(L.sK[m * 72 + k]) * __expf(L.sG[32 * 65 + k] - L.sG[m * 65 + k])); }, r, h);
#pragma unroll
      for (int i = 0; i < 16; ++i) { const int n = 32 * ti + crow(i, h), m = 32 * tj + r; sAtt[n * 72 + m] = (m <= n) ? f2bf(acc[i]) : (u16)0; }
    } else {
#pragma unroll
      for (int i = 0; i < 16; ++i) sAtt[(crow(i, h)) * 72 + 32 + r] = 0;
    }
  }
  __syncthreads();
  {
    const int tn = wid >> 2, te = wid & 3;
    f32x16 acc;
#pragma unroll
    for (int i = 0; i < 16; ++i) acc[i] = 0.f;
    mma_tile<4>(acc, [&](int i, int k) { const int n = 32 * tn + i; return f2bf(bf2f(L.sQ[n * 72 + k]) * __expf(L.sG[n * 65 + k])); },
                [&](int k, int j) { return sS[k * 136 + 32 * te + j]; }, r, h);
    mma_tile<4>(acc, [&](int i, int k) { return sAtt[(32 * tn + i) * 72 + k]; },
                [&](int k, int j) { return L.sV[k * 136 + 32 * te + j]; }, r, h);
#pragma unroll
    for (int i = 0; i < 16; ++i) sO[(32 * tn + crow(i, h)) * 132 + 32 * te + r] = acc[i];
  }
  __syncthreads();
  {
    const int n = tid >> 3, g = tid & 7;
    float v[16], ss = 0.f;
#pragma unroll
    for (int j = 0; j < 16; ++j) { v[j] = sO[n * 132 + g * 16 + j]; ss += v[j] * v[j]; }
    ss += __shfl_xor(ss, 1); ss += __shfl_xor(ss, 2); ss += __shfl_xor(ss, 4);
    const float rs = rsqrtf(ss * (1.f / 128.f) + 1e-6f);
    if (n < ci.valid) {
      const int tok = ci.tok0 + n;
      const u16* gp = (const u16*)(ws + OFF_PGATE) + (size_t)tok * 1024 + hd * 128 + g * 16;
      const uint4 g0 = *(const uint4*)gp, g1 = *(const uint4*)(gp + 8);
      const unsigned gg[8] = {g0.x, g0.y, g0.z, g0.w, g1.x, g1.y, g1.z, g1.w};
      unsigned o[8];
#pragma unroll
      for (int j = 0; j < 8; ++j) {
        const float ga = bflo(gg[j]), gb = bfhi(gg[j]);
        const float a = v[2 * j] * rs * p.gla_norm_w[g * 16 + 2 * j] * (ga * __builtin_amdgcn_rcpf(1.f + __expf(-ga)));
        const float b = v[2 * j + 1] * rs * p.gla_norm_w[g * 16 + 2 * j + 1] * (gb * __builtin_amdgcn_rcpf(1.f + __expf(-gb)));
        o[j] = pk2(a, b);
      }
      u16* op = (u16*)(ws + OFF_O) + (size_t)tok * 1024 + hd * 128 + g * 16;
      *(uint4*)op = make_uint4(o[0], o[1], o[2], o[3]);
      *(uint4*)(op + 8) = make_uint4(o[4], o[5], o[6], o[7]);
    }
  }
  __syncthreads();
}

constexpr int PF = 3;
template <int NCHUNKS, int ROLE>
DI void chain_loop(const Params& p, int c0, int sb, int hd, int t, int w, int lane, bf16x8* spbuf) {
  const int r = lane & 31, hh = lane >> 5;
  const bool sample = NCHUNKS == 1;
  const size_t offA = (ROLE == 0 ? (size_t)t * 8192 : 65536 + (size_t)t * 8192) + (size_t)lane * 16;
  const size_t offB = (ROLE == 0 ? 32768 + (size_t)(w * 4 + t) * 2048 : 81920 + (size_t)(w * 2 + t) * 2048) + (size_t)lane * 32;
  f32x16 S;
#pragma unroll
  for (int i = 0; i < 16; ++i)
    S[i] = (sample && ROLE == 0) ? p.state_gdn[((size_t)(sb * 4 + hd) * 128 + 32 * t + crow(i, hh)) * 128 + 32 * w + r] : 0.f;
  const float* GDEC = (const float*)(p.ws + OFF_GDEC);
  u16* O2 = (u16*)(p.ws + OFF_R1);
  bf16x8 ra[PF][8];
  uint4 rb[PF][2];
  float rdec[PF];
#define CH_LOAD(slot, cc)                                                                              \
  if (ROLE != 2) {                                                                                     \
    const int cq_ = (cc) < NCHUNKS ? (cc) : NCHUNKS - 1;                                               \
    const int ch_ = (c0 + cq_) * 4 + hd;                                                               \
    const char* gi_ = p.ws + OFF_GI + (size_t)ch_ * 98304;                                             \
    _Pragma("unroll") for (int ks = 0; ks < 8; ++ks) ra[slot][ks] = *(const bf16x8*)(gi_ + offA + ks * 1024); \
    rb[slot][0] = *(const uint4*)(gi_ + offB); rb[slot][1] = *(const uint4*)(gi_ + offB + 16);        \
    rdec[slot] = GDEC[ch_];                                                                            \
  }
#define CH_STEP(u, c)                                                                                  \
  {                                                                                                    \
    CH_LOAD((u + PF - 1) % PF, (c) + PF - 1);                                                          \
    bf16x8* sp = spbuf + ((c) & 1) * 512;                                                              \
    if (ROLE == 0) { sp[(2 * t) * 64 + lane] = pack8(S, 0); sp[(2 * t + 1) * 64 + lane] = pack8(S, 1); } \
    LDS_BARRIER();                                                                                     \
    if (ROLE != 2) {                                                                                   \
      const unsigned bb[8] = {rb[u][0].x, rb[u][0].y, rb[u][0].z, rb[u][0].w, rb[u][1].x, rb[u][1].y, rb[u][1].z, rb[u][1].w}; \
      const float dec = rdec[u];                                                                       \
      f32x16 acc0;                                                                                     \
      _Pragma("unroll") for (int j = 0; j < 8; ++j) { acc0[2 * j] = S[2 * j] * dec + bflo(bb[j]); acc0[2 * j + 1] = S[2 * j + 1] * dec + bfhi(bb[j]); } \
      _Pragma("unroll") for (int ks = 0; ks < 8; ++ks) acc0 = MFMA(ra[u][ks], sp[ks * 64 + lane], acc0); \
      if (ROLE == 0) {                                                                                 \
        S = acc0;                                                                                      \
      } else {                                                                                         \
        const int tok0_ = sample ? T_P + sb * 32 : (c0 + (c)) * 64;                                    \
        _Pragma("unroll") for (int i = 0; i < 16; ++i) {                                               \
          const int n = 32 * t + crow(i, hh);                                                          \
          if (!sample || n < 32) O2[(size_t)(tok0_ + n) * 512 + hd * 128 + 32 * w + r] = f2bf(acc0[i]); \
        }                                                                                              \
      }                                                                                                \
    }                                                                                                  \
  }
#pragma unroll
  for (int u = 0; u < PF - 1; ++u) { CH_LOAD(u, u); }
  constexpr int NMAIN = (NCHUNKS / PF) * PF;
#pragma unroll 1
  for (int cb = 0; cb < NMAIN; cb += PF) {
    CH_STEP(0, cb);
    CH_STEP(1, cb + 1);
    CH_STEP(2, cb + 2);
  }
  if (NCHUNKS - NMAIN >= 1) CH_STEP(0, NMAIN);
  if (NCHUNKS - NMAIN >= 2) CH_STEP(1, NMAIN + 1);
#undef CH_STEP
#undef CH_LOAD
  if (ROLE == 0) {
    float* dst = p.out + (sample ? OUT_GDN_S : OUT_GDN_P) + (size_t)(sb * 4 + hd) * 16384;
#pragma unroll
    for (int i = 0; i < 16; ++i) dst[(32 * t + crow(i, hh)) * 128 + 32 * w + r] = S[i];
  }
}

template <int NCHUNKS>
DI void gdn_chain2(const Params& p, int chain, int w, char* smem) {
  int tid = threadIdx.x;
  asm volatile("" : "+v"(tid));
  const int lane = tid & 63, wid = __builtin_amdgcn_readfirstlane(tid >> 6);
  bf16x8* spbuf = (bf16x8*)smem;
  int sb, hd, c0;
  if (NCHUNKS != 1) { sb = chain >> 2; hd = chain & 3; c0 = sb * 128; }
  else { sb = (chain - 16) >> 2; hd = (chain - 16) & 3; c0 = 512 + sb; }
  if (wid < 4) chain_loop<NCHUNKS, 0>(p, c0, sb, hd, wid, w, lane, spbuf);
  else if (wid < 6) chain_loop<NCHUNKS, 1>(p, c0, sb, hd, wid - 4, w, lane, spbuf);
  else chain_loop<NCHUNKS, 2>(p, c0, sb, hd, 0, w, lane, spbuf);
  __syncthreads();
}

DI void phase3(const Params& p, char* smem) {
  const int tid = threadIdx.x;
  const int b = blockIdx.x;
  if (b < 64) {
    const int x = b & 7, j = b >> 3;
    gdn_chain2<128>(p, x * 2 + (j >> 2), j & 3, smem);
#ifdef REP_P3
    gdn_chain2<128>(p, x * 2 + (j >> 2), j & 3, smem);
#endif
    for (int u = b; u < 128; u += 64) gdn_chain2<1>(p, 16 + (u >> 2), u & 3, smem);
    return;
  }
  const int nb = gridDim.x - 64;
  for (int u = 128 + (b - 64); u < 256; u += nb) gdn_chain2<1>(p, 16 + (u >> 2), u & 3, smem);
  const int gt = (b - 64) * NTHR + tid, gn = nb * NTHR;
  float* GB = p.out + OOFF_GB;
  const float* GLD = p.out + OOFF_GLD;
  for (int e = gt; e < 16 * 2048; e += gn) {
    const int sh = e >> 11, de4 = e & 2047, d = de4 >> 5;
    const int seq = sh >> 2, hd = sh & 3;
    float4 S = make_float4(0.f, 0.f, 0.f, 0.f);
    for (int cl = 0; cl < 128; cl += 16) {
      float4 bn[16];
      float dc[16];
#pragma unroll
      for (int u = 0; u < 16; ++u) {
        const int ch = (seq * 128 + cl + u) * 4 + hd;
        bn[u] = ((const float4*)(GB + (size_t)ch * 8192))[de4];
        dc[u] = GLD[(size_t)ch * 64 + d];
      }
#pragma unroll
      for (int u = 0; u < 16; ++u) {
        const int ch = (seq * 128 + cl + u) * 4 + hd;
        ((float4*)(GB + (size_t)ch * 8192))[de4] = S;
        S.x = dc[u] * S.x + bn[u].x; S.y = dc[u] * S.y + bn[u].y; S.z = dc[u] * S.z + bn[u].z; S.w = dc[u] * S.w + bn[u].w;
      }
    }
    ((float4*)(p.out + OUT_GLA_P + (size_t)sh * 8192))[de4] = S;
  }
  for (int e = gt; e < 64 * 2048; e += gn) {
    const int sh = e >> 11, de4 = e & 2047, d = de4 >> 5;
    const int sb = sh >> 2, hd = sh & 3;
    const int ch = (512 + sb) * 4 + hd;
    const float4 S0 = ((const float4*)(p.state_gla + (size_t)sh * 8192))[de4];
    const float4 bnew = ((const float4*)(GB + (size_t)ch * 8192))[de4];
    const float dec = GLD[(size_t)ch * 64 + d];
    ((float4*)(GB + (size_t)ch * 8192))[de4] = S0;
    ((float4*)(p.out + OUT_GLA_S + (size_t)sh * 8192))[de4] = make_float4(dec * S0.x + bnew.x, dec * S0.y + bnew.y, dec * S0.z + bnew.z, dec * S0.w + bnew.w);
  }
  {
    unsigned* ctr = (unsigned*)(p.ws + OFF_BAR);
    asm volatile("s_waitcnt vmcnt(0)" ::: "memory");
    __syncthreads();
    if (tid == 0) {
      __builtin_amdgcn_fence(__ATOMIC_RELEASE, "agent");
      asm volatile("s_waitcnt vmcnt(0)" ::: "memory");
      __hip_atomic_fetch_add(ctr, 1u, __ATOMIC_RELAXED, __HIP_MEMORY_SCOPE_AGENT);
      unsigned sp = 0;
      while (__hip_atomic_load(ctr, __ATOMIC_RELAXED, __HIP_MEMORY_SCOPE_AGENT) < (unsigned)nb) { __builtin_amdgcn_s_sleep(2); if (++sp > (1u << 22)) break; }
      __builtin_amdgcn_fence(__ATOMIC_ACQUIRE, "agent");
      asm volatile("s_waitcnt vmcnt(0)" ::: "memory");
    }
    __syncthreads();
  }
  for (int u = b - 64; u < NCH; u += nb) gla_out(p, u >> 2, u & 3, smem);
}

DI void phase4_misc(const Params& p) {
  const int tid = threadIdx.x, lane = tid & 63;
  for (int i = blockIdx.x * NTHR + tid; i < T_ALL; i += gridDim.x * NTHR) ((float*)(p.ws + OFF_RSS))[i] = 0.f;
  const int gw = blockIdx.x * (NTHR / 64) + (tid >> 6), nw = gridDim.x * (NTHR / 64);
  const u16* O2 = (const u16*)(p.ws + OFF_R1);
  const u16* PGATE = (const u16*)(p.ws + OFF_PGATE);
  u16* O = (u16*)(p.ws + OFF_O);
  for (int tok = gw; tok < T_ALL; tok += nw) {
    const uint4 ov = *(const uint4*)(O2 + (size_t)tok * 512 + lane * 8);
    const uint4 zv = *(const uint4*)(PGATE + (size_t)tok * 1024 + 512 + lane * 8);
    const unsigned oo[4] = {ov.x, ov.y, ov.z, ov.w}, zz[4] = {zv.x, zv.y, zv.z, zv.w};
    float v[8], ss = 0.f;
#pragma unroll
    for (int j = 0; j < 4; ++j) { v[2 * j] = bflo(oo[j]); v[2 * j + 1] = bfhi(oo[j]); ss += v[2 * j] * v[2 * j] + v[2 * j + 1] * v[2 * j + 1]; }
    ss += __shfl_xor(ss, 1); ss += __shfl_xor(ss, 2); ss += __shfl_xor(ss, 4); ss += __shfl_xor(ss, 8);
    const float rs = rsqrtf(ss * (1.f / 128.f) + 1e-6f);
    unsigned o[4];
#pragma unroll
    for (int j = 0; j < 4; ++j) {
      const float za = bflo(zz[j]), zb = bfhi(zz[j]);
      const int e = (lane & 15) * 8 + 2 * j;
      const float a = v[2 * j] * rs * p.gdn_norm_w[e] * (za * __builtin_amdgcn_rcpf(1.f + __expf(-za)));
      const float b = v[2 * j + 1] * rs * p.gdn_norm_w[e + 1] * (zb * __builtin_amdgcn_rcpf(1.f + __expf(-zb)));
      o[j] = pk2(a, b);
    }
    *(uint4*)(O + (size_t)tok * 1024 + 512 + lane * 8) = make_uint4(o[0], o[1], o[2], o[3]);
  }
}

DI void conv_state_out(const Params& p) {
  const int gtid = blockIdx.x * NTHR + threadIdx.x, gn = gridDim.x * NTHR;
  const u16* PGDN = (const u16*)(p.ws + OFF_PGDN);
  for (int e = gtid; e < 4 * 3 * 1536; e += gn) {
    const int col = e % 1536, j = (e / 1536) % 3, b = e / (3 * 1536);
    p.out[OUT_CONV_P + e] = bf2f(PGDN[(size_t)(b * 8192 + 8189 + j) * 1536 + col]);
  }
  for (int e = gtid; e < 16 * 3 * 1536; e += gn) {
    const int col = e % 1536, j = (e / 1536) % 3, b = e / (3 * 1536);
    p.out[OUT_CONV_S + e] = bf2f(PGDN[(size_t)(T_P + b * 32 + 29 + j) * 1536 + col]);
  }
}

DI unsigned dpp_max_row(unsigned v) {
  v = max(v, (unsigned)__builtin_amdgcn_update_dpp(0, (int)v, 0xB1, 0xF, 0xF, false));
  v = max(v, (unsigned)__builtin_amdgcn_update_dpp(0, (int)v, 0x4E, 0xF, 0xF, false));
  v = max(v, (unsigned)__builtin_amdgcn_update_dpp(0, (int)v, 0x141, 0xF, 0xF, false));
  v = max(v, (unsigned)__builtin_amdgcn_update_dpp(0, (int)v, 0x140, 0xF, 0xF, false));
  return v;
}
DI float dpp_sum_row(float v) {
  v += __builtin_bit_cast(float, __builtin_amdgcn_update_dpp(0, __builtin_bit_cast(int, v), 0xB1, 0xF, 0xF, false));
  v += __builtin_bit_cast(float, __builtin_amdgcn_update_dpp(0, __builtin_bit_cast(int, v), 0x4E, 0xF, 0xF, false));
  v += __builtin_bit_cast(float, __builtin_amdgcn_update_dpp(0, __builtin_bit_cast(int, v), 0x141, 0xF, 0xF, false));
  v += __builtin_bit_cast(float, __builtin_amdgcn_update_dpp(0, __builtin_bit_cast(int, v), 0x140, 0xF, 0xF, false));
  return v;
}
DI unsigned mkkey(float f, int c) { unsigned u = __float_as_uint(f); u = (u >> 31) ? ~u : (u | 0x80000000u); return (u & 0xFFFFFF00u) | (unsigned)(255 - c); }
DI float keyval(unsigned k) { const unsigned u = k & 0xFFFFFF00u; return __uint_as_float((u >> 31) ? (u & 0x7FFFFFFFu) : ~u); }
DI int keyidx(unsigned k) { return 255 - (int)(k & 255u); }
DI void ce_desc(unsigned& a, unsigned& b) { const unsigned hi = max(a, b), lo = min(a, b); a = hi; b = lo; }
DI void sort8_desc(unsigned (&k)[8]) {
  ce_desc(k[0], k[1]); ce_desc(k[2], k[3]); ce_desc(k[4], k[5]); ce_desc(k[6], k[7]);
  ce_desc(k[0], k[2]); ce_desc(k[1], k[3]); ce_desc(k[4], k[6]); ce_desc(k[5], k[7]);
  ce_desc(k[1], k[2]); ce_desc(k[5], k[6]);
  ce_desc(k[0], k[4]); ce_desc(k[1], k[5]); ce_desc(k[2], k[6]); ce_desc(k[3], k[7]);
  ce_desc(k[2], k[4]); ce_desc(k[3], k[5]);
  ce_desc(k[1], k[2]); ce_desc(k[3], k[4]); ce_desc(k[5], k[6]);
}
DI unsigned top16_sorted8(unsigned (&k)[8], int l16) {
  unsigned res = 0;
  for (int rnd = 0; rnd < 16; ++rnd) {
    const unsigned m = dpp_max_row(k[0]);
    if (l16 == rnd) res = m;
    const bool win = (k[0] == m);
#pragma unroll
    for (int s = 0; s < 7; ++s) k[s] = win ? k[s + 1] : k[s];
    k[7] = win ? 0u : k[7];
  }
  return res;
}

DI void pop_round(unsigned (&k)[8], unsigned& res, int l16, int rnd) {
  const unsigned m = dpp_max_row(k[0]);
  if (l16 == rnd) res = m;
  const bool win = (k[0] == m);
#pragma unroll
  for (int s = 0; s < 7; ++s) k[s] = win ? k[s + 1] : k[s];
  k[7] = win ? 0u : k[7];
}

DI void peer_select(const Params& p, int tile, int hd, char* smem, bool load_keys) {
  u16* sK1 = (u16*)smem;
  u16* sK2 = sK1 + 128 * 136;
  u16* sQ = sK2 + 128 * 136;
  float* sS = (float*)(sQ + 64 * 264);
  int tid = threadIdx.x;
  asm volatile("" : "+v"(tid));
  char* ws = p.ws;
  float* outp = p.out;
  asm volatile("" : "+s"(ws), "+s"(outp));
  const int lane = tid & 63, wid = tid >> 6, r = lane & 31, h = lane >> 5;
  const u16* QP = (const u16*)(ws + OFF_QP);
  const u16* K12 = (const u16*)(ws + OFF_K12);
  const int tok0 = tile * 64;
  for (int e = tid; e < 64 * 32; e += NTHR) {
    const int n = e >> 5, g = e & 31;
    *(uint4*)(sQ + n * 264 + g * 8) = *(const uint4*)(QP + (size_t)(tok0 + n) * 2048 + hd * 256 + g * 8);
  }
  if (load_keys) {
    for (int e = tid; e < 2 * 128 * 16; e += NTHR) {
      const int which = e >> 11, n = (e >> 4) & 127, g = e & 15;
      *(uint4*)(sK1 + which * 128 * 136 + n * 136 + g * 8) = *(const uint4*)(K12 + ((size_t)(which * 8 + hd) * 128 + n) * 128 + g * 8);
    }
  }
  __syncthreads();
  const int l16 = lane & 15, rowb = lane & 48;
  const int tl0 = wid * 8 + (lane >> 4), tl1 = tl0 + 4;
  unsigned ka[8], kb[8], kc[8], kd[8];
  {
    const int tt = wid >> 2, tk = wid & 3;
    f32x16 acc1, acc2;
#pragma unroll
    for (int i = 0; i < 16; ++i) { acc1[i] = 0.f; acc2[i] = 0.f; }
    mma_tile_vec<8>(acc1, sQ + (32 * tt) * 264, 264, sK1 + (32 * tk) * 136, 136, r, h);
    mma_tile_vec<8>(acc2, sQ + (32 * tt) * 264 + 128, 264, sK2 + (32 * tk) * 136, 136, r, h);
#pragma unroll
    for (int i = 0; i < 16; ++i) sS[(32 * tt + crow(i, h)) * 132 + 32 * tk + r] = acc1[i];
    __syncthreads();
#pragma unroll
    for (int s = 0; s < 8; ++s) { const int cc = s * 16 + l16; ka[s] = mkkey(sS[tl0 * 132 + cc], cc); kc[s] = mkkey(sS[tl1 * 132 + cc], cc); }
    __syncthreads();
#pragma unroll
    for (int i = 0; i < 16; ++i) sS[(32 * tt + crow(i, h)) * 132 + 32 * tk + r] = acc2[i];
    __syncthreads();
#pragma unroll
    for (int s = 0; s < 8; ++s) { const int cc = s * 16 + l16; kb[s] = mkkey(sS[tl0 * 132 + cc], cc); kd[s] = mkkey(sS[tl1 * 132 + cc], cc); }
  }
  int* EIDX = (int*)(ws + OFF_EIDX);
  float* GATE = (float*)(ws + OFF_GATE);
  {
    sort8_desc(ka); sort8_desc(kb); sort8_desc(kc); sort8_desc(kd);
    unsigned ra = 0, rb = 0, rc = 0, rd = 0;
    for (int rnd = 0; rnd < 16; ++rnd) {
      pop_round(ka, ra, l16, rnd); pop_round(kb, rb, l16, rnd); pop_round(kc, rc, l16, rnd); pop_round(kd, rd, l16, rnd);
    }
    const float v1[2] = {keyval(ra), keyval(rc)}, v2[2] = {keyval(rb), keyval(rd)};
    const int i1[2] = {keyidx(ra), keyidx(rc)}, i2[2] = {keyidx(rb), keyidx(rd)};
    int ptr[2] = {0, 0};
    unsigned hk[2], r3[2] = {0u, 0u};
#pragma unroll
    for (int gq = 0; gq < 2; ++gq) hk[gq] = mkkey(__shfl(v1[gq], rowb) + v2[gq], l16);
    for (int rnd = 0; rnd < 16; ++rnd) {
#pragma unroll
      for (int gq = 0; gq < 2; ++gq) {
        const unsigned m = dpp_max_row(hk[gq]);
        if (l16 == rnd) r3[gq] = m;
        ptr[gq] += (hk[gq] == m) ? 1 : 0;
        const float va = __shfl(v1[gq], rowb + (ptr[gq] & 15));
        hk[gq] = (ptr[gq] < 16) ? mkkey(va + v2[gq], ptr[gq] * 16 + l16) : 0u;
      }
    }
#pragma unroll
    for (int gq = 0; gq < 2; ++gq) {
      const int cc = keyidx(r3[gq]);
      const float sc = keyval(r3[gq]);
      const int ia = __shfl(i1[gq], rowb + (cc >> 4)), ib = __shfl(i2[gq], rowb + (cc & 15));
      const float mx = __shfl(sc, rowb);
      const float ex = __expf(sc - mx);
      const float sum = dpp_sum_row(ex);
      const size_t o = ((size_t)(tok0 + (gq ? tl1 : tl0)) * 8 + hd) * 16 + l16;
      EIDX[o] = ia * 128 + ib;
      GATE[o] = ex / sum;
    }
  }
  __syncthreads();
}

DI void unpack_fp8x16(const uint4& a, f32x2* f) {
  f[0] = __builtin_amdgcn_cvt_pk_f32_fp8((int)a.x, false); f[1] = __builtin_amdgcn_cvt_pk_f32_fp8((int)a.x, true);
  f[2] = __builtin_amdgcn_cvt_pk_f32_fp8((int)a.y, false); f[3] = __builtin_amdgcn_cvt_pk_f32_fp8((int)a.y, true);
  f[4] = __builtin_amdgcn_cvt_pk_f32_fp8((int)a.z, false); f[5] = __builtin_amdgcn_cvt_pk_f32_fp8((int)a.z, true);
  f[6] = __builtin_amdgcn_cvt_pk_f32_fp8((int)a.w, false); f[7] = __builtin_amdgcn_cvt_pk_f32_fp8((int)a.w, true);
}
DI float wave_sum_dpp(float v) {
  v = dpp_sum_row(v);
  const int b = __builtin_bit_cast(int, v);
  return __builtin_bit_cast(float, __builtin_amdgcn_readlane(b, 0)) + __builtin_bit_cast(float, __builtin_amdgcn_readlane(b, 16)) +
         __builtin_bit_cast(float, __builtin_amdgcn_readlane(b, 32)) + __builtin_bit_cast(float, __builtin_amdgcn_readlane(b, 48));
}
constexpr int GB8 = 16;
DI void phase8(const Params& p) {
  const int tid = threadIdx.x, lane = tid & 63;
  const int gw = blockIdx.x * (NTHR / 64) + (tid >> 6), nw = gridDim.x * (NTHR / 64);
  const u16* H2 = (const u16*)(p.ws + OFF_H2);
  const unsigned char* UB = (const unsigned char*)(p.ws + OFF_UB);
  const unsigned char* VB = (const unsigned char*)(p.ws + OFF_VB);
  const float* USC = (const float*)(p.ws + OFF_USC);
  const float* VSC = (const float*)(p.ws + OFF_VSC);
  const int* EIDX = (const int*)(p.ws + OFF_EIDX);
  const float* GATE = (const float*)(p.ws + OFF_GATE);
  for (int tok = gw; tok < T_ALL; tok += nw) {
    f32x2 hx[8];
    {
      float t[16];
      const uint4* hp = (const uint4*)(H2 + (size_t)tok * 1024 + lane * 16);
      unpack16(hp[0], hp[1], t);
      const float rsn = rsqrtf(((const float*)(p.ws + OFF_RSS))[tok] * (1.f / 1024.f) + 1e-6f);
#pragma unroll
      for (int j = 0; j < 8; ++j) { hx[j].x = t[2 * j] * rsn; hx[j].y = t[2 * j + 1] * rsn; }
    }
    const int e0 = EIDX[(size_t)tok * 128 + lane], e1 = EIDX[(size_t)tok * 128 + 64 + lane];
    const int g0 = __builtin_bit_cast(int, GATE[(size_t)tok * 128 + lane]), g1 = __builtin_bit_cast(int, GATE[(size_t)tok * 128 + 64 + lane]);
    f32x2 acc[8];
#pragma unroll
    for (int j = 0; j < 8; ++j) { acc[j].x = 0.f; acc[j].y = 0.f; }
    for (int rp = 0; rp < REP_P8; ++rp) {
#pragma unroll
    for (int j = 0; j < 8; ++j) { acc[j].x = 0.f; acc[j].y = 0.f; }
    for (int j0 = 0; j0 < 128; j0 += GB8) {
      const int ee = (j0 < 64) ? e0 : e1, gg = (j0 < 64) ? g0 : g1;
      uint4 uq[GB8], vq[GB8];
      float gt[GB8], us[GB8];
#pragma unroll
      for (int u = 0; u < GB8; ++u) {
        const int e = __builtin_amdgcn_readlane(ee, (j0 & 63) + u);
        const float g = __builtin_bit_cast(float, __builtin_amdgcn_readlane(gg, (j0 & 63) + u));
        uq[u] = *(const uint4*)(UB + (size_t)e * 1024 + lane * 16);
        vq[u] = *(const uint4*)(VB + (size_t)e * 1024 + lane * 16);
        gt[u] = g * VSC[e];
        us[u] = USC[e];
      }
#pragma unroll
      for (int u = 0; u < GB8; ++u) {
        f32x2 f[8];
        unpack_fp8x16(uq[u], f);
        f32x2 d2 = f[0] * hx[0];
#pragma unroll
        for (int j = 1; j < 8; ++j) d2 += f[j] * hx[j];
        float d = wave_sum_dpp(d2.x + d2.y) * us[u];
        const float z = 1.5957691216057308f * (d + 0.044715f * d * d * d);
        const float act = d * __builtin_amdgcn_rcpf(1.f + __expf(-z));
        const float wgt = gt[u] * act;
        unpack_fp8x16(vq[u], f);
#pragma unroll
        for (int j = 0; j < 8; ++j) acc[j] += f[j] * wgt;
      }
    }
    }
    float* yr = p.out + OUT_Y + (size_t)tok * 1024 + lane * 16;
    float y[16], ss = 0.f;
#pragma unroll
    for (int q = 0; q < 4; ++q) {
      const float4 xv = ((const float4*)yr)[q];
      y[4 * q] = xv.x + acc[2 * q].x; y[4 * q + 1] = xv.y + acc[2 * q].y; y[4 * q + 2] = xv.z + acc[2 * q + 1].x; y[4 * q + 3] = xv.w + acc[2 * q + 1].y;
    }
#pragma unroll
    for (int j = 0; j < 16; ++j) ss += y[j] * y[j];
    ss = wave_sum(ss);
    const float rs = rsqrtf(ss * (1.f / 1024.f) + 1e-6f);
#pragma unroll
    for (int q = 0; q < 4; ++q) {
      const float4 ww = ((const float4*)(p.norm_final_w + lane * 16))[q];
      float4 o;
      o.x = y[4 * q] * rs * ww.x; o.y = y[4 * q + 1] * rs * ww.y; o.z = y[4 * q + 2] * rs * ww.z; o.w = y[4 * q + 3] * rs * ww.w;
      ((float4*)yr)[q] = o;
    }
  }
}


#define XB_TMO      128
#define XB_XCNT(j)  (256  + 64 * (j))
#define XB_XSUB(j)  (1280 + 64 * (j))
#define XB_XGEN(j)  (2304 + 64 * (j))
#define XB_TOP      3328
#define XB_TOPGEN   3392
#define XCD_BAR_WORDS 3456
#define XB_SPIN_CAP (1u << 18)
#define LAS __attribute__((address_space(3)))
DI unsigned xb_ld(unsigned* p) { return __hip_atomic_load(p, __ATOMIC_RELAXED, __HIP_MEMORY_SCOPE_AGENT); }
DI unsigned xb_add(unsigned* p, unsigned v) { return __hip_atomic_fetch_add(p, v, __ATOMIC_RELAXED, __HIP_MEMORY_SCOPE_AGENT); }
DI unsigned xb_xcc_id() { return (unsigned)__builtin_amdgcn_s_getreg((3 << 11) | 20) & 0xFu; }
#define XB_SPIN(cond, bar) do { unsigned _sp = 0; while (cond) { __builtin_amdgcn_s_sleep(1); \
    if ((++_sp & 255u) == 0u) { if (xb_ld(&(bar)[XB_TMO])) break; if (_sp > XB_SPIN_CAP) { atomicAdd(&(bar)[XB_TMO], 1u); break; } } } } while (0)
struct XcdBarrier { unsigned* bar; unsigned x; volatile LAS unsigned* st; };
DI XcdBarrier xcd_barrier_post(unsigned* bar, volatile LAS unsigned* st) {
  XcdBarrier b; b.bar = bar; b.x = xb_xcc_id(); b.st = st;
  if (threadIdx.x == 0) (void)xb_add(&bar[XB_XCNT(b.x)], 1u);
  return b;
}
DI void xcd_barrier_complete(unsigned* bar, unsigned x, unsigned& nloc, unsigned& nx) {
  const unsigned G = gridDim.x * gridDim.y * gridDim.z;
  unsigned sum, cnt, mine, sp = 0u;
  for (;;) {
    sum = 0u; cnt = 0u; mine = 0u;
#pragma unroll
    for (unsigned j = 0; j < 16; ++j) { const unsigned c = xb_ld(&bar[XB_XCNT(j)]); sum += c; cnt += (c > 0u) ? 1u : 0u; mine = (j == x) ? c : mine; }
    if (sum == G) break;
    __builtin_amdgcn_s_sleep(1);
    if ((++sp & 255u) == 0u) { if (xb_ld(&bar[XB_TMO])) break; if (sp > XB_SPIN_CAP) { atomicAdd(&bar[XB_TMO], 1u); break; } }
  }
  nloc = mine > 0u ? mine : 1u; nx = cnt > 0u ? cnt : 1u;
}
DI void xcd_barrier(const XcdBarrier& b) {
  asm volatile("s_waitcnt vmcnt(0)" ::: "memory");
  __syncthreads();
  if (threadIdx.x == 0) {
    unsigned* bar = b.bar;
    __builtin_amdgcn_s_waitcnt(0);
    unsigned nloc = b.st[0], nx = b.st[1];
    if (nloc == 0u) { xcd_barrier_complete(bar, b.x, nloc, nx); b.st[0] = nloc; b.st[1] = nx; }
    const unsigned old = xb_add(&bar[XB_XSUB(b.x)], 1u);
    const unsigned gen = old / nloc;
    if (old + 1u == (gen + 1u) * nloc) {
      __builtin_amdgcn_fence(__ATOMIC_RELEASE, "agent");
      asm volatile("s_waitcnt vmcnt(0)" ::: "memory");
      const unsigned og = xb_add(&bar[XB_TOP], 1u);
      const unsigned tg = og / nx;
      if (og + 1u == (tg + 1u) * nx) xb_add(&bar[XB_TOPGEN], 1u);
      else XB_SPIN(xb_ld(&bar[XB_TOPGEN]) == tg, bar);
      __builtin_amdgcn_fence(__ATOMIC_ACQUIRE, "agent");
      xb_add(&bar[XB_XGEN(b.x)], 1u);
      asm volatile("s_waitcnt vmcnt(0)" ::: "memory");
    } else {
      XB_SPIN(xb_ld(&bar[XB_XGEN(b.x)]) == gen, bar);
      __builtin_amdgcn_fence(__ATOMIC_ACQUIRE, "agent");
      asm volatile("s_waitcnt vmcnt(0)" ::: "memory");
    }
  }
  __syncthreads();
}

__global__ void __launch_bounds__(NTHR) mega(Params p) {
  extern __shared__ __attribute__((aligned(16))) char smem[];
  cg::grid_group grid = cg::this_grid();
  __shared__ uint4 xb_words;
  if (threadIdx.x == 0) xb_words = make_uint4(0u, 0u, 0u, 0u);
  __syncthreads();
  if (blockIdx.x == 0) for (int i = threadIdx.x; i < XCD_BAR_WORDS; i += NTHR) ((unsigned*)(p.ws + OFF_BAR))[i] = 0u;
  phase0(p);
  grid.sync();
  const XcdBarrier xb = xcd_barrier_post((unsigned*)(p.ws + OFF_BAR), (volatile LAS unsigned*)&xb_words);
#if REP_P0 > 1
  phase0(p);
  xcd_barrier(xb);
#endif
  for (int rp = 0; rp < REP_P1; ++rp) {
    u16* PGLA = (u16*)(p.ws + OFF_PGLA); u16* PGATE = (u16*)(p.ws + OFF_PGATE); u16* PGDN = (u16*)(p.ws + OFF_PGDN);
    float* PSM = p.out + OOFF_PSMALL;
    gemm_phase((const u16*)(p.ws + OFF_R1), (const u16*)(p.ws + OFF_WIN), 3712,
               [&](int row, int col, const f32x16 (&acc)[2][2]) {
                 const int ct = col & ~127;
                 if (ct < 1024) store_tile_bf16<1024>(PGLA + (size_t)row * 1024 + col, acc);
                 else if (ct < 2048) store_tile_bf16<1024>(PGATE + (size_t)row * 1024 + (col - 1024), acc);
                 else if (ct < 3584) store_tile_bf16<1536>(PGDN + (size_t)row * 1536 + (col - 2048), acc);
                 else if (col < 3616) {
#pragma unroll
                   for (int mi = 0; mi < 2; ++mi)
#pragma unroll
                     for (int i = 0; i < 16; ++i) PSM[(size_t)(row + mi * 32 + (i & 3) + 8 * (i >> 2)) * 32 + (col - 3584)] = acc[mi][0][i];
                 }
               }, smem);
    xcd_barrier(xb);
  }
  conv_state_out(p);
  for (int rp = 0; rp < REP_P2L; ++rp) {
    for (int u = blockIdx.x; u < NCH; u += gridDim.x) gla_prep(p, u >> 2, u & 3, smem);
    if (rp + 1 < REP_P2L) xcd_barrier(xb);
  }
  for (int rp = 0; rp < REP_P2G; ++rp) {
    for (int u = gridDim.x - 1 - blockIdx.x; u < NCH; u += gridDim.x) gdn_prep(p, u >> 2, u & 3, smem);
    if (rp + 1 < REP_P2G) xcd_barrier(xb);
  }
  xcd_barrier(xb);
  phase3(p, smem);
  xcd_barrier(xb);
  for (int rp = 0; rp < REP_P4B; ++rp) {
    phase4_misc(p);
    xcd_barrier(xb);
  }
  for (int rp = 0; rp < REP_P5; ++rp) {
    float* X1 = p.out + OUT_Y;
    u16* H2u = (u16*)(p.ws + OFF_H2);
    float* RSS = (float*)(p.ws + OFF_RSS);
    gemm_phase((const u16*)(p.ws + OFF_O), (const u16*)(p.ws + OFF_WOUT), 1024,
               [&](int row, int col, const f32x16 (&acc)[2][2]) {
                 float* q0 = X1 + (size_t)row * 1024 + col;
                 const float* x0 = xrow(p, row) + col;
                 u16* h0 = H2u + (size_t)row * 1024 + col;
                 const float wf0 = p.norm_ffn_w[col], wf1 = p.norm_ffn_w[col + 32];
                 const int lane_ = threadIdx.x & 63;
#pragma unroll
                 for (int mi = 0; mi < 2; ++mi)
#pragma unroll
                   for (int g = 0; g < 4; ++g)
#pragma unroll
                     for (int j = 0; j < 4; ++j) {
                       size_t off = (size_t)(mi * 32 + 8 * g + j) * 1024;
                       asm volatile("" : "+v"(off));
                       const float v0 = x0[off] + acc[mi][0][4 * g + j], v1 = x0[off + 32] + acc[mi][1][4 * g + j];
                       q0[off] = v0; q0[off + 32] = v1;
                       h0[off] = f2bf(v0 * wf0); h0[off + 32] = f2bf(v1 * wf1);
                       float sq = dpp_sum_row(v0 * v0 + v1 * v1);
                       sq += __shfl_xor(sq, 16);
                       if ((lane_ & 31) == 0) atomicAdd(RSS + row + mi * 32 + 8 * g + j, sq);
                     }
               }, smem);
  xcd_barrier(xb);
  }
  for (int rp = 0; rp < REP_P6; ++rp) {
    u16* QP = (u16*)(p.ws + OFF_QP);
    gemm_phase((const u16*)(p.ws + OFF_H2), (const u16*)(p.ws + OFF_WQ), 2048,
               [&](int row, int col, const f32x16 (&acc)[2][2]) {
                 const float* RSS = (const float*)(p.ws + OFF_RSS);
#pragma unroll
                 for (int mi = 0; mi < 2; ++mi)
#pragma unroll
                   for (int g = 0; g < 4; ++g)
#pragma unroll
                     for (int j = 0; j < 4; ++j) {
                       const int rr = row + mi * 32 + 8 * g + j;
                       const float rs = rsqrtf(RSS[rr] * (1.f / 1024.f) + 1e-6f);
                       u16* q = QP + (size_t)rr * 2048 + col;
                       asm volatile("" : "+v"(q));
                       q[0] = f2bf(acc[mi][0][4 * g + j] * rs);
                       q[32] = f2bf(acc[mi][1][4 * g + j] * rs);
                     }
               }, smem);
  xcd_barrier(xb);
  }
  for (int rp = 0; rp < REP_P7; ++rp) {
    int khd = -1;
    for (int u = blockIdx.x; u < 520 * 8; u += gridDim.x) { peer_select(p, u >> 3, u & 7, smem, (u & 7) != khd); khd = u & 7; }
    xcd_barrier(xb);
  }
#ifdef REP_SYNC
  for (int i = 0; i < REP_SYNC; ++i) xcd_barrier(xb);
#endif
  phase8(p);
}

extern "C" void kernel_launch(void* const* d_in, const int* in_sizes, int n_in, void* d_out, int out_size, void* d_ws,
                              size_t ws_size, hipStream_t stream) {
  static int grid_blocks = 0;
  if (!grid_blocks) {
    int dev = 0, cus = 0, per_cu = 0;
    (void)hipGetDevice(&dev);
    (void)hipDeviceGetAttribute(&cus, hipDeviceAttributeMultiprocessorCount, dev);
    (void)hipFuncSetAttribute((const void*)mega, hipFuncAttributeMaxDynamicSharedMemorySize, (int)LDS_BYTES);
    (void)hipOccupancyMaxActiveBlocksPerMultiprocessor(&per_cu, mega, NTHR, LDS_BYTES);
    if (per_cu < 1) per_cu = 1;
    grid_blocks = cus * per_cu;
    if (ws_size < WS_NEED) fprintf(stderr, "workspace too small: %zu < %zu\n", ws_size, (size_t)WS_NEED);
  }
  Params p{};
  const float** pp = (const float**)&p;
  for (int i = 0; i < 22; ++i) pp[i] = (const float*)d_in[i];
  p.out = (float*)d_out;
  p.ws = (char*)d_ws;
  void* args[] = {&p};
  hipError_t e = hipLaunchCooperativeKernel((void*)mega, dim3(grid_blocks), dim3(NTHR), args, LDS_BYTES, stream);
  if (e != hipSuccess) fprintf(stderr, "cooperative launch failed: %s (grid %d)\n", hipGetErrorString(e), grid_blocks);
}
```
